# Optimizing an MI355X kernel written in HIP

```python
import math
import jax, jax.numpy as jnp
from jax import lax
import numpy as np

D_MODEL = 1024
BATCH = 16
SEQ = 2048
DEPTH = 2
DEC_BATCH = 8
DEC_SEQ = 16
PAST_LEN = 2048

CHUNK = 64
Q_BLOCK = 128
A_HEADS = 4
A_HALF_DIM = 64
A_QK_DIM = 2 * A_HALF_DIM
A_V_DIM = 2 * A_HALF_DIM
A_WIDTH = A_HEADS * A_V_DIM
LAMBDA_INIT_0 = 0.2
N_BUCKETS = 32
MAX_DISTANCE = 128
B_GROUPS = 4
B_GROUP_DIM = 128
B_WIDTH = B_GROUPS * B_GROUP_DIM
B_CHUNK = 128
L0_SIZES = [A_HEADS * A_QK_DIM, A_HEADS * A_QK_DIM, A_WIDTH, A_WIDTH, B_WIDTH, B_WIDTH, B_WIDTH]
L0_SPLITS = [int(s) for s in np.cumsum(L0_SIZES)[:-1]]
L0_IN = int(sum(L0_SIZES))
C_WIDTH = D_MODEL
CONV_WIDTH = 31
L1_IN = 3 * C_WIDTH
RMS_EPS = 1e-6
LN_EPS = 1e-5

kernel_name = "hybrid_stream_diffattn_gmlp_conformer_step"


def _rmsnorm(x, g):
    xf = x.astype(jnp.float32)
    y = xf * lax.rsqrt(jnp.mean(xf * xf, axis=-1, keepdims=True) + RMS_EPS)
    return (y * g.astype(jnp.float32)).astype(x.dtype)


def _layernorm(x, g, b):
    xf = x.astype(jnp.float32)
    mu = jnp.mean(xf, axis=-1, keepdims=True)
    var = jnp.mean(jnp.square(xf - mu), axis=-1, keepdims=True)
    y = (xf - mu) * lax.rsqrt(var + LN_EPS) * g.astype(jnp.float32) + b.astype(jnp.float32)
    return y.astype(x.dtype)


def _t5_bucket(rel):
    nb = N_BUCKETS // 2
    ret = jnp.where(rel > 0, nb, 0)
    n = jnp.abs(rel)
    max_exact = nb // 2
    nf = jnp.maximum(n, 1).astype(jnp.float32)
    large = max_exact + (jnp.log(nf / max_exact) / math.log(MAX_DISTANCE / max_exact)
                         * (nb - max_exact)).astype(jnp.int32)
    large = jnp.minimum(large, nb - 1)
    return ret + jnp.where(n < max_exact, n, large)


def _diff_attn(q, k, v, q_pos, k_pos, rel_bias, lam):
    s = jnp.einsum('bqhcd,bkhcd->bhcqk', q, k).astype(jnp.float32) * (A_HALF_DIM ** -0.5)
    bias = rel_bias[_t5_bucket(k_pos[None, :] - q_pos[:, None])]
    s = s + jnp.transpose(bias, (2, 0, 1)).astype(jnp.float32)[None, :, None]
    allowed = (k_pos[None, :] // CHUNK) <= (q_pos[:, None] // CHUNK)
    s = jnp.where(allowed[None, None, None], s, -jnp.inf)
    p = jax.nn.softmax(s, axis=-1)
    w = p[:, :, 0] - lam * p[:, :, 1]
    return jnp.einsum('bhqk,bkhe->bqhe', w.astype(v.dtype), v)


def _spatial_gate(v, w_s, b_s):
    bsz, t, g, c = v.shape
    n = -(-t // B_CHUNK)
    pad = n * B_CHUNK - t
    vp = jnp.pad(v, ((0, 0), (0, pad), (0, 0), (0, 0))).reshape(bsz, n, B_CHUNK, g, c)
    causal = jnp.tril(jnp.ones((B_CHUNK, B_CHUNK), dtype=bool))
    wm = jnp.where(causal[None], w_s, 0).astype(v.dtype)
    s = jnp.einsum('gij,bnjgc->bnigc', wm, vp) + b_s.T.astype(v.dtype)[None, None, :, :, None]
    return s.reshape(bsz, n * B_CHUNK, g, c)[:, :t]


def _attn_gmlp_layer(x, cache_k, cache_v, rel_bias, lam, norm_g, w_in, subln_g,
                     gv_ln_g, gv_ln_b, w_s, b_s, w_out):
    bsz, t, _ = x.shape
    xn = _rmsnorm(x, norm_g)
    z = jnp.einsum('btd,de->bte', xn, w_in)
    q, k, v, g_a, u_b, v_b, g_b = jnp.split(z, L0_SPLITS, axis=-1)
    q = q.reshape(bsz, t, A_HEADS, 2, A_HALF_DIM)
    k_new = k.reshape(bsz, t, A_HEADS, A_QK_DIM)
    v_new = v.reshape(bsz, t, A_HEADS, A_V_DIM)
    if cache_k is None:
        past = 0
        k_all, v_all = k_new, v_new
    else:
        past = cache_k.shape[1]
        k_all = jnp.concatenate([cache_k.astype(k_new.dtype), k_new], axis=1)
        v_all = jnp.concatenate([cache_v.astype(v_new.dtype), v_new], axis=1)
    q_pos = past + jnp.arange(t, dtype=jnp.int32)
    k_pos = jnp.arange(past + t, dtype=jnp.int32)
    k_all5 = k_all.reshape(bsz, past + t, A_HEADS, 2, A_HALF_DIM)
    if t % Q_BLOCK == 0:
        n_blk = t // Q_BLOCK
        qb = jnp.moveaxis(q.reshape(bsz, n_blk, Q_BLOCK, A_HEADS, 2, A_HALF_DIM), 1, 0)
        pb = q_pos.reshape(n_blk, Q_BLOCK)
        o = lax.map(lambda a: _diff_attn(a[0], k_all5, v_all, a[1], k_pos, rel_bias, lam), (qb, pb))
        o = jnp.moveaxis(o, 0, 1).reshape(bsz, t, A_HEADS, A_V_DIM)
    else:
        o = _diff_attn(q, k_all5, v_all, q_pos, k_pos, rel_bias, lam)
    o = _rmsnorm(o, subln_g) * (1.0 - LAMBDA_INIT_0)
    out_a = o.reshape(bsz, t, A_WIDTH) * jax.nn.silu(g_a)
    zu = jax.nn.gelu(u_b).reshape(bsz, t, B_GROUPS, B_GROUP_DIM)
    zv = _layernorm(jax.nn.gelu(v_b).reshape(bsz, t, B_GROUPS, B_GROUP_DIM), gv_ln_g, gv_ln_b)
    out_b = (zu * _spatial_gate(zv, w_s, b_s)).reshape(bsz, t, B_WIDTH) * jax.nn.silu(g_b)
    y = x + jnp.einsum('bte,ed->btd', jnp.concatenate([out_a, out_b], axis=-1), w_out)
    return y, k_new, v_new, zv.reshape(bsz, t, B_WIDTH)


def _conv_layer(x, conv_state, norm_g, w_in, w_dw, b_dw, ln_g, ln_b, w_out):
    xn = _rmsnorm(x, norm_g)
    z = jnp.einsum('btd,de->bte', xn, w_in)
    a, b, g = jnp.split(z, [C_WIDTH, 2 * C_WIDTH], axis=-1)
    u = a * jax.nn.sigmoid(b)
    if conv_state is None:
        ctx = jnp.pad(u, ((0, 0), (CONV_WIDTH - 1, 0), (0, 0)))
    else:
        ctx = jnp.concatenate([conv_state.astype(u.dtype), u], axis=1)
    c = lax.conv_general_dilated(ctx, w_dw.astype(ctx.dtype)[:, None, :], window_strides=(1,),
                                 padding='VALID', dimension_numbers=('NWC', 'WIO', 'NWC'),
                                 feature_group_count=C_WIDTH) + b_dw.astype(ctx.dtype)
    c = jax.nn.silu(_layernorm(c, ln_g, ln_b)) * jax.nn.silu(g)
    y = x + jnp.einsum('btc,cd->btd', c, w_out)
    return y, ctx[:, -(CONV_WIDTH - 1):]


def setup_inputs(seed: int = 0) -> dict:
    key = jax.random.key(seed)
    ks = jax.random.split(key, 26)

    def nrm(k, shape, s):
        return jax.random.normal(k, shape, jnp.float32) * s

    return {
        "x_prompt": nrm(ks[0], (BATCH, SEQ, D_MODEL), 1.0),
        "x_sample": nrm(ks[1], (DEC_BATCH, DEC_SEQ, D_MODEL), 1.0),
        "cache_k0": nrm(ks[2], (DEC_BATCH, PAST_LEN, A_HEADS, A_QK_DIM), 1.0),
        "cache_v0": nrm(ks[3], (DEC_BATCH, PAST_LEN, A_HEADS, A_V_DIM), 1.0),
        "state_conv1": nrm(ks[4], (DEC_BATCH, CONV_WIDTH - 1, C_WIDTH), 0.5),
        "rel_bias": nrm(ks[5], (N_BUCKETS, A_HEADS), 0.5),
        "norm_g0": 1.0 + nrm(ks[6], (D_MODEL,), 0.02),
        "w_in0": nrm(ks[7], (D_MODEL, L0_IN), D_MODEL ** -0.5),
        "lambda_q1": nrm(ks[8], (A_HALF_DIM,), 0.1),
        "lambda_k1": nrm(ks[9], (A_HALF_DIM,), 0.1),
        "lambda_q2": nrm(ks[10], (A_HALF_DIM,), 0.1),
        "lambda_k2": nrm(ks[11], (A_HALF_DIM,), 0.1),
        "subln_g0": 1.0 + nrm(ks[12], (A_V_DIM,), 0.02),
        "gv_ln_g0": 1.0 + nrm(ks[13], (B_GROUPS, B_GROUP_DIM), 0.02),
        "gv_ln_b0": nrm(ks[14], (B_GROUPS, B_GROUP_DIM), 0.02),
        "w_s0": nrm(ks[15], (B_GROUPS, B_CHUNK, B_CHUNK), B_CHUNK ** -0.5),
        "b_s0": 1.0 + nrm(ks[16], (B_GROUPS, B_CHUNK), 0.1),
        "w_out0": nrm(ks[17], (A_WIDTH + B_WIDTH, D_MODEL), (A_WIDTH + B_WIDTH) ** -0.5),
        "norm_g1": 1.0 + nrm(ks[18], (D_MODEL,), 0.02),
        "w_in1": nrm(ks[19], (D_MODEL, L1_IN), D_MODEL ** -0.5),
        "w_dw1": nrm(ks[20], (CONV_WIDTH, C_WIDTH), CONV_WIDTH ** -0.5),
        "b_dw1": nrm(ks[21], (C_WIDTH,), 0.02),
        "conv_ln_g1": 1.0 + nrm(ks[22], (C_WIDTH,), 0.02),
        "conv_ln_b1": nrm(ks[23], (C_WIDTH,), 0.02),
        "w_out1": nrm(ks[24], (C_WIDTH, D_MODEL), C_WIDTH ** -0.5),
        "final_g": 1.0 + nrm(ks[25], (D_MODEL,), 0.02),
    }


def reference(x_prompt, x_sample, cache_k0, cache_v0, state_conv1, rel_bias, norm_g0, w_in0,
              lambda_q1, lambda_k1, lambda_q2, lambda_k2, subln_g0, gv_ln_g0, gv_ln_b0, w_s0, b_s0,
              w_out0, norm_g1, w_in1, w_dw1, b_dw1, conv_ln_g1, conv_ln_b1, w_out1, final_g):
    f32 = jnp.float32
    lam = (jnp.exp(jnp.sum(lambda_q1.astype(f32) * lambda_k1.astype(f32)))
           - jnp.exp(jnp.sum(lambda_q2.astype(f32) * lambda_k2.astype(f32))) + LAMBDA_INIT_0)
    xp, xs = x_prompt, x_sample
    for layer in range(DEPTH):
        if layer % 2 == 0:
            xp, k0p, v0p, _ = _attn_gmlp_layer(xp, None, None, rel_bias, lam, norm_g0, w_in0,
                                               subln_g0, gv_ln_g0, gv_ln_b0, w_s0, b_s0, w_out0)
            xs, k0s, v0s, gv0s = _attn_gmlp_layer(xs, cache_k0, cache_v0, rel_bias, lam, norm_g0,
                                                  w_in0, subln_g0, gv_ln_g0, gv_ln_b0, w_s0, b_s0,
                                                  w_out0)
        else:
            xp, c1p = _conv_layer(xp, None, norm_g1, w_in1, w_dw1, b_dw1, conv_ln_g1, conv_ln_b1, w_out1)
            xs, c1s = _conv_layer(xs, state_conv1, norm_g1, w_in1, w_dw1, b_dw1, conv_ln_g1,
                                  conv_ln_b1, w_out1)
    y_prompt = _rmsnorm(xp, final_g)
    y_sample = _rmsnorm(xs, final_g)
    return (y_prompt, y_sample, k0p, v0p, c1p, k0s, v0s, gv0s, c1s)
```

```cpp
#include <hip/hip_runtime.h>
#include <cstdio>
#include <cstdint>

constexpr int DM = 1024;
constexpr int SEQ = 2048, NB = 16;
constexpr int SB = 8, ST = 16, PAST = 2048;
constexpr int MP = NB * SEQ;
constexpr int MS = SB * ST;
constexpr int MV = MP + MS;
constexpr int MPAD = 33024;
constexpr int L0N = 3584, L1N = 3072;
constexpr int CW = 31;
constexpr float RMS_EPS = 1e-6f, LN_EPS = 1e-5f;
constexpr float C2 = 0.125f * 1.4426950408889634f;
constexpr float LOG2E = 1.4426950408889634f;
constexpr size_t OFF_YP = 0, OFF_YS = (size_t)MP * DM, OFF_K0P = OFF_YS + (size_t)MS * DM, OFF_V0P = OFF_K0P + (size_t)MP * 512,
                 OFF_C1P = OFF_V0P + (size_t)MP * 512, OFF_K0S = OFF_C1P + (size_t)NB * 30 * DM, OFF_V0S = OFF_K0S + (size_t)MS * 512,
                 OFF_GVS = OFF_V0S + (size_t)MS * 512, OFF_C1S = OFF_GVS + (size_t)MS * 512, OUT_TOTAL = OFF_C1S + (size_t)SB * 30 * DM;
static_assert(OUT_TOTAL == 68173824, "output size");
namespace pg8 {
#define PG8_LAS __attribute__((address_space(3)))
typedef unsigned short bf16_t;
typedef short bf16x8 __attribute__((ext_vector_type(8)));
typedef float f32x4 __attribute__((ext_vector_type(4)));
typedef unsigned u32x4 __attribute__((ext_vector_type(4)));
constexpr int BM = 256, BK = 64, HALF = 128, HTB = HALF * BK * 2  , STAGE_BYTES = 8 * HTB, NXCD = 8, WGM = 8;

__host__ __device__ __forceinline__ int lds_byte(int r, int c) { const int st = (r >> 4) * 2 + (c >> 5), rr = r & 15, cc = c & 31, ob = rr * 64 + cc * 2; return st * 1024 + (ob ^ (((ob >> 9) & 1) << 5)); }
__host__ __device__ __forceinline__ void stage_rc(int b, int& R, int& C) { const int st = b / 1024, sb = b % 1024, swz = sb ^ (((sb >> 9) & 1) << 5); R = (st >> 1) * 16 + swz / 64; C = (st & 1) * 32 + (swz % 64) / 2; }
__host__ __device__ __forceinline__ int perm32(int rho) { const int n = rho >> 4, i = rho & 15; return 8 * (i >> 2) + 4 * n + (i & 3); }

struct Unit { int pm, pn; };
struct Gemm { const bf16_t* A; const bf16_t* Bt; int M, N, K; };

struct StaticOrder {
    int nM, nN, nwg, G, c;
    __host__ __device__ void init(int M, int N, int G_, int c_) { nM = M / BM; nN = N / BM; nwg = nM * nN; G = G_; c = c_; }
    __host__ __device__ bool next(int i, Unit& u) const {
        const long L = (long)i * G + c; if (L >= nwg) return false;
        int wgid = (int)L; { const int q = nwg / NXCD, r = nwg % NXCD, xcd = wgid % NXCD, off = wgid / NXCD; wgid = (xcd < r ? xcd * (q + 1) : r * (q + 1) + (xcd - r) * q) + off; }
        const int nig = WGM * nN, gid = wgid / nig, fm = gid * WGM, gsz = (nM - fm) < WGM ? (nM - fm) : WGM;
        u.pm = fm + ((wgid % nig) % gsz); u.pn = (wgid % nig) / gsz; return true;
    }
    __device__ __forceinline__ void a_ready(const Unit&) const {}
    __device__ __forceinline__ void done(const Unit&) const {}
};

__device__ __forceinline__ unsigned cvt_pk_bf16(float lo, float hi) { unsigned r; asm volatile("v_cvt_pk_bf16_f32 %0, %1, %2" : "=v"(r) : "v"(lo), "v"(hi)); return r; }
__device__ __forceinline__ float sigmoid_f(float x) { return __builtin_amdgcn_rcpf(1.f + __builtin_amdgcn_exp2f(-LOG2E * x)); }
__device__ __forceinline__ float silu_f(float x) { return x * sigmoid_f(x); }
__device__ __forceinline__ float gelu_f(float x) { const float t = x * (-2.302208198f - 0.1029432397f * x * x); return x * __builtin_amdgcn_rcpf(1.f + __builtin_amdgcn_exp2f(t)); }
__device__ __forceinline__ u32x4 pack8(const f32x4& a, const f32x4& b) { u32x4 w; w.x = cvt_pk_bf16(a[0], a[1]); w.y = cvt_pk_bf16(a[2], a[3]); w.z = cvt_pk_bf16(b[0], b[1]); w.w = cvt_pk_bf16(b[2], b[3]); return w; }

struct EpiL0In {
    static constexpr bool PERM = true, AFTER_DRAIN = false;
    bf16_t* act; float* out;
    template <int KIND> __device__ __forceinline__ void body(const f32x4 (&acc)[2][2][4][2], const Unit& u, int wr, int wc, int fr, int fq) const {
        const int row0 = u.pm * BM + wr * 64 + fr, col0 = u.pn * BM + wc * 32 + 8 * fq;
#pragma unroll
        for (int ai = 0; ai < 2; ++ai)
#pragma unroll
            for (int m = 0; m < 4; ++m) { const int R = row0 + ai * HALF + m * 16; bf16_t* rowp = act + (size_t)R * L0N + col0;
#pragma unroll
                for (int bj = 0; bj < 2; ++bj) { f32x4 v0 = acc[ai][bj][m][0], v1 = acc[ai][bj][m][1];
                    if (KIND == 0) { v0 = v0 * C2; v1 = v1 * C2; }
                    if (KIND == 1) {
                        const int kv = (u.pn >> 1) - 1, kc = col0 + bj * HALF - 512 * (kv + 1);
                        if (R < MP) { float* d = out + (kv ? OFF_V0P : OFF_K0P) + (size_t)R * 512 + kc; *(f32x4*)d = v0; *(f32x4*)(d + 4) = v1; }
                        else if (R < MV) { float* d = out + (kv ? OFF_V0S : OFF_K0S) + (size_t)(R - MP) * 512 + kc; *(f32x4*)d = v0; *(f32x4*)(d + 4) = v1; }
                    }
                    if (KIND == 2) {
#pragma unroll
                        for (int j = 0; j < 4; ++j) { v0[j] = silu_f(v0[j]); v1[j] = silu_f(v1[j]); } }
                    if (KIND == 3) {
#pragma unroll
                        for (int j = 0; j < 4; ++j) { v0[j] = gelu_f(v0[j]); v1[j] = gelu_f(v1[j]); } }
                    *(u32x4*)(rowp + bj * HALF) = pack8(v0, v1); } }
    }
    __device__ __forceinline__ void operator()(const f32x4 (&acc)[2][2][4][2], const Unit& u, int wr, int wc, int fr, int fq) const {
        const int kind = u.pn >> 1;
        if (kind == 0) body<0>(acc, u, wr, wc, fr, fq);
        else if (kind == 1 || kind == 2) body<1>(acc, u, wr, wc, fr, fq);
        else if (kind == 3 || kind == 6) body<2>(acc, u, wr, wc, fr, fq);
        else body<3>(acc, u, wr, wc, fr, fq);
    }
};

template <bool FIRST> struct EpiRes {
    static constexpr bool PERM = true, AFTER_DRAIN = false;
    const float* xp; const float* xs; float* out; bf16_t* yb; float* rss;
    __device__ __forceinline__ void operator()(const f32x4 (&acc)[2][2][4][2], const Unit& u, int wr, int wc, int fr, int fq) const {
        const int row0 = u.pm * BM + wr * 64 + fr, col0 = u.pn * BM + wc * 32 + 8 * fq;
#pragma unroll
        for (int ai = 0; ai < 2; ++ai)
#pragma unroll
            for (int m = 0; m < 4; ++m) { const int R = row0 + ai * HALF + m * 16; const bool valid = R < MV;
                float* yrow = (R < MP ? out + OFF_YP + (size_t)R * DM : out + OFF_YS + (size_t)(R - MP) * DM) + col0;
                const float* brow = FIRST ? ((R < MP ? xp + (size_t)R * DM : xs + (size_t)(R - MP) * DM) + col0) : yrow;
                float ss = 0.f;
#pragma unroll
                for (int bj = 0; bj < 2; ++bj) { f32x4 v0 = acc[ai][bj][m][0], v1 = acc[ai][bj][m][1];
                    if (valid) { v0 = v0 + *(const f32x4*)(brow + bj * HALF); v1 = v1 + *(const f32x4*)(brow + bj * HALF + 4);
                        *(f32x4*)(yrow + bj * HALF) = v0; *(f32x4*)(yrow + bj * HALF + 4) = v1; }
                    ss += (v0[0] * v0[0] + v0[1] * v0[1]) + (v0[2] * v0[2] + v0[3] * v0[3]) + (v1[0] * v1[0] + v1[1] * v1[1]) + (v1[2] * v1[2] + v1[3] * v1[3]);
                    if (FIRST) *(u32x4*)(yb + (size_t)R * DM + col0 + bj * HALF) = pack8(v0, v1); }
                ss += __shfl_xor(ss, 16); ss += __shfl_xor(ss, 32);
                if (fq == 0 && valid) atomicAdd(rss + R, ss);
                asm volatile("" ::: "memory"); }
    }
};

struct EpiL1In {
    static constexpr bool PERM = true, AFTER_DRAIN = false;
    const float* rss; bf16_t* U; bf16_t* SG; float* out;
    __device__ __forceinline__ void operator()(const f32x4 (&acc)[2][2][4][2], const Unit& u, int wr, int wc, int fr, int fq) const {
        const int row0 = u.pm * BM + wr * 64 + fr;
        if (u.pn < 8) {
            const int ch = u.pn * HALF + wc * 32 + 8 * fq;
#pragma unroll
            for (int ai = 0; ai < 2; ++ai)
#pragma unroll
                for (int m = 0; m < 4; ++m) { const int R = row0 + ai * HALF + m * 16; const float rs = 1.0f / sqrtf(rss[R] * (1.0f / DM) + RMS_EPS);
                    f32x4 u0, u1;
#pragma unroll
                    for (int j = 0; j < 4; ++j) { u0[j] = (acc[ai][0][m][0][j] * rs) * sigmoid_f(acc[ai][1][m][0][j] * rs); u1[j] = (acc[ai][0][m][1][j] * rs) * sigmoid_f(acc[ai][1][m][1][j] * rs); }
                    *(u32x4*)(U + (size_t)R * DM + ch) = pack8(u0, u1);
                    if (R < MP) { const int t = R & (SEQ - 1); if (t >= SEQ - 30) { float* d = out + OFF_C1P + ((size_t)(R >> 11) * 30 + (t - (SEQ - 30))) * DM + ch; *(f32x4*)d = u0; *(f32x4*)(d + 4) = u1; } }
                    else if (R < MV) { const int s = R - MP; float* d = out + OFF_C1S + ((size_t)(s >> 4) * 30 + 14 + (s & 15)) * DM + ch; *(f32x4*)d = u0; *(f32x4*)(d + 4) = u1; } }
        } else {
            const int ch = (u.pn - 8) * BM + wc * 32 + 8 * fq;
#pragma unroll
            for (int ai = 0; ai < 2; ++ai)
#pragma unroll
                for (int m = 0; m < 4; ++m) { const int R = row0 + ai * HALF + m * 16; const float rs = 1.0f / sqrtf(rss[R] * (1.0f / DM) + RMS_EPS);
#pragma unroll
                    for (int bj = 0; bj < 2; ++bj) { f32x4 v0 = acc[ai][bj][m][0] * rs, v1 = acc[ai][bj][m][1] * rs;
#pragma unroll
                        for (int j = 0; j < 4; ++j) { v0[j] = silu_f(v0[j]); v1[j] = silu_f(v1[j]); }
                        *(u32x4*)(SG + (size_t)R * DM + ch + bj * HALF) = pack8(v0, v1); } }
        }
    }
};
template <class Epi, class Sched, bool ALIGN_EPI = false, bool SP2 = false>
__device__ __forceinline__ void gemm_phase(PG8_LAS unsigned char* lds, const Gemm g, const Sched& S, const Epi& E) {
    const int tid = threadIdx.x, wid = __builtin_amdgcn_readfirstlane(tid >> 6), lane = tid & 63, wr = wid >> 2, wc = wid & 3, fr = lane & 15, fq = lane >> 4;
    const int K = g.K, nt = K / BK;
    unsigned voffA[2], voffB[2];
#pragma unroll
    for (int i = 0; i < 2; ++i) { int R, C; stage_rc(tid * 16 + i * 8192, R, C); const int Rb = Epi::PERM ? ((R & ~31) + perm32(R & 31)) : R;
        voffA[i] = (unsigned)(R * K + C) * 2u; voffB[i] = (unsigned)(Rb * K + C) * 2u; }
    const size_t kstep = (size_t)(BK * 2);
    const size_t hstep = (size_t)HALF * K * 2;
    const size_t tstep = 2 * hstep;
    const unsigned ldsw = (unsigned)wid * 1024u;
    const int aoff = lds_byte(wr * 64 + fr, fq * 8), boff = lds_byte(wc * 32 + fr, fq * 8);
#define PG8_SA(b, h) (((b) * 2 + (h)) * HTB)
#define PG8_SB(b, h) ((4 + (b) * 2 + (h)) * HTB)
#define PG8_STAGE(bufoff, gbase, voff) do { _Pragma("unroll") for (int _i = 0; _i < 2; ++_i) \
        __builtin_amdgcn_global_load_lds((const unsigned*)((const char*)(gbase) + (voff)[_i]), (PG8_LAS unsigned*)(lds + (bufoff) + ldsw + _i * 8192), 16, 0, 0); } while (0)
#define PG8_LDA(dst, b, h) do { _Pragma("unroll") for (int m = 0; m < 4; ++m) _Pragma("unroll") for (int k = 0; k < 2; ++k) dst[m][k] = *(const PG8_LAS bf16x8*)(lds + PG8_SA(b, h) + aoff + m * 2048 + k * 1024); } while (0)
#define PG8_LDB(dst, b, h) do { _Pragma("unroll") for (int n = 0; n < 2; ++n) _Pragma("unroll") for (int k = 0; k < 2; ++k) dst[n][k] = *(const PG8_LAS bf16x8*)(lds + PG8_SB(b, h) + boff + n * 2048 + k * 1024); } while (0)
#define PG8_MMA(ai, bj, At, Bt) do { __builtin_amdgcn_s_setprio(1); _Pragma("unroll") for (int m = 0; m < 4; ++m) _Pragma("unroll") for (int n = 0; n < 2; ++n) _Pragma("unroll") for (int k = 0; k < 2; ++k) \
        acc[ai][bj][m][n] = __builtin_amdgcn_mfma_f32_16x16x32_bf16(Bt[n][k], At[m][k], acc[ai][bj][m][n], 0, 0, 0); __builtin_amdgcn_s_setprio(0); } while (0)
#define PG8_WAIT_V(n) asm volatile("s_waitcnt vmcnt(" #n ")" ::: "memory")
#define PG8_WAIT_L(n) asm volatile("s_waitcnt lgkmcnt(" #n ")" ::: "memory")
#define PG8_BAR __builtin_amdgcn_s_barrier()
#define PG8_SCHED __builtin_amdgcn_sched_barrier(0)
    Unit cur, nxt; int ui = 0;
    if (!S.next(0, cur)) return;
    f32x4 acc[2][2][4][2];
#pragma unroll
    for (int a = 0; a < 2; ++a)
#pragma unroll
        for (int b = 0; b < 2; ++b)
#pragma unroll
            for (int m = 0; m < 4; ++m)
#pragma unroll
                for (int n = 0; n < 2; ++n) acc[a][b][m][n] = (f32x4){0.f, 0.f, 0.f, 0.f};
    bf16x8 At[4][2], B0[2][2], B1[2][2];
    const char* cA = (const char*)g.A + (size_t)cur.pm * tstep; const char* cB = (const char*)g.Bt + (size_t)cur.pn * tstep;
    S.a_ready(cur);
    if constexpr (SP2) {
        PG8_STAGE(PG8_SB(0, 0), cB, voffB); PG8_STAGE(PG8_SB(0, 1), cB + hstep, voffB); PG8_STAGE(PG8_SA(0, 0), cA, voffA); PG8_STAGE(PG8_SA(0, 1), cA + hstep, voffA);
        if (wr == 1) PG8_BAR;
        PG8_WAIT_V(2); PG8_BAR;
        PG8_STAGE(PG8_SB(1, 0), cB + kstep, voffB); PG8_STAGE(PG8_SA(1, 0), cA + kstep, voffA); PG8_STAGE(PG8_SB(1, 1), cB + hstep + kstep, voffB);
        PG8_WAIT_V(6); PG8_BAR;
    } else {
        PG8_STAGE(PG8_SB(0, 0), cB, voffB); PG8_STAGE(PG8_SA(0, 0), cA, voffA); PG8_STAGE(PG8_SB(0, 1), cB + hstep, voffB); PG8_STAGE(PG8_SA(0, 1), cA + hstep, voffA);
        if (wr == 1) PG8_BAR;
        PG8_WAIT_V(4); PG8_BAR;
        PG8_STAGE(PG8_SB(1, 0), cB + kstep, voffB); PG8_STAGE(PG8_SA(1, 0), cA + kstep, voffA); PG8_STAGE(PG8_SB(1, 1), cB + hstep + kstep, voffB);
        PG8_WAIT_V(6); PG8_BAR;
    }
    for (;;) {
        const bool has_next = S.next(ui + 1, nxt);
        const char* nA = has_next ? (const char*)g.A + (size_t)nxt.pm * tstep : cA; const char* nB = has_next ? (const char*)g.Bt + (size_t)nxt.pn * tstep : cB;
        for (int t = 0; t < nt; t += 2) {
            const bool last = (t == nt - 2);
            const char* a1 = cA + (size_t)(t + 1) * kstep;
            const char* a2 = last ? nA : cA + (size_t)(t + 2) * kstep; const char* b2 = last ? nB : cB + (size_t)(t + 2) * kstep;
            const char* a3 = a2 + kstep; const char* b3 = b2 + kstep;
            if (last && has_next) S.a_ready(nxt);
            if constexpr (SP2) {
            PG8_LDB(B0, 0, 0); PG8_LDB(B1, 0, 1); PG8_SCHED; PG8_LDA(At, 0, 0); PG8_STAGE(PG8_SA(1, 1), a1 + hstep, voffA);
            PG8_WAIT_V(8); PG8_WAIT_L(0); PG8_BAR; PG8_MMA(0, 0, At, B0); PG8_MMA(0, 1, At, B1); PG8_BAR; PG8_SCHED;
            PG8_LDA(At, 0, 1); PG8_STAGE(PG8_SB(0, 0), b2, voffB); PG8_STAGE(PG8_SB(0, 1), b2 + hstep, voffB); PG8_STAGE(PG8_SA(0, 0), a2, voffA);
            PG8_WAIT_V(8); PG8_WAIT_L(0); PG8_BAR; PG8_MMA(1, 0, At, B0); PG8_MMA(1, 1, At, B1); PG8_BAR; PG8_SCHED;
            PG8_LDB(B0, 1, 0); PG8_LDB(B1, 1, 1); PG8_SCHED; PG8_LDA(At, 1, 0); PG8_STAGE(PG8_SA(0, 1), a2 + hstep, voffA);
            PG8_WAIT_V(8); PG8_WAIT_L(0); PG8_BAR; PG8_MMA(0, 0, At, B0); PG8_MMA(0, 1, At, B1); PG8_BAR; PG8_SCHED;
            PG8_LDA(At, 1, 1); PG8_STAGE(PG8_SB(1, 0), b3, voffB); PG8_STAGE(PG8_SB(1, 1), b3 + hstep, voffB); PG8_STAGE(PG8_SA(1, 0), a3, voffA);
            PG8_WAIT_V(8); PG8_WAIT_L(0); PG8_BAR; PG8_MMA(1, 0, At, B0); PG8_MMA(1, 1, At, B1); PG8_BAR; PG8_SCHED;
            } else {
            PG8_LDB(B0, 0, 0); PG8_SCHED; PG8_LDA(At, 0, 0); PG8_STAGE(PG8_SA(1, 1), a1 + hstep, voffA);
            PG8_WAIT_L(8); PG8_BAR; PG8_WAIT_L(0); PG8_MMA(0, 0, At, B0); PG8_BAR; PG8_SCHED;
            PG8_LDB(B1, 0, 1); PG8_STAGE(PG8_SB(0, 0), b2, voffB);
            PG8_BAR; PG8_WAIT_L(0); PG8_MMA(0, 1, At, B1); PG8_BAR;
            PG8_LDA(At, 0, 1); PG8_STAGE(PG8_SA(0, 0), a2, voffA);
            PG8_BAR; PG8_WAIT_L(0); PG8_MMA(1, 0, At, B0); PG8_BAR; PG8_SCHED;
            PG8_STAGE(PG8_SB(0, 1), b2 + hstep, voffB);
            PG8_WAIT_V(6); PG8_BAR; PG8_MMA(1, 1, At, B1); PG8_BAR;
            PG8_LDB(B0, 1, 0); PG8_SCHED; PG8_LDA(At, 1, 0); PG8_STAGE(PG8_SA(0, 1), a2 + hstep, voffA);
            PG8_WAIT_L(8); PG8_BAR; PG8_WAIT_L(0); PG8_MMA(0, 0, At, B0); PG8_BAR; PG8_SCHED;
            PG8_LDB(B1, 1, 1); PG8_STAGE(PG8_SB(1, 0), b3, voffB);
            PG8_BAR; PG8_WAIT_L(0); PG8_MMA(0, 1, At, B1); PG8_BAR;
            PG8_LDA(At, 1, 1); PG8_STAGE(PG8_SA(1, 0), a3, voffA);
            PG8_BAR; PG8_WAIT_L(0); PG8_MMA(1, 0, At, B0); PG8_BAR; PG8_SCHED;
            PG8_STAGE(PG8_SB(1, 1), b3 + hstep, voffB);
            PG8_WAIT_V(6); PG8_BAR; PG8_MMA(1, 1, At, B1); PG8_BAR;
            }
        }
        if constexpr (ALIGN_EPI) { if (wr == 0) PG8_BAR; }
        if constexpr (!Epi::AFTER_DRAIN) { E(acc, cur, wr, wc, fr, fq); S.done(cur); }
        if (!has_next) break;
#pragma unroll
        for (int a = 0; a < 2; ++a)
#pragma unroll
            for (int b = 0; b < 2; ++b)
#pragma unroll
                for (int m = 0; m < 4; ++m)
#pragma unroll
                    for (int n = 0; n < 2; ++n) acc[a][b][m][n] = (f32x4){0.f, 0.f, 0.f, 0.f};
        cur = nxt; cA = nA; cB = nB; ++ui;
        if constexpr (ALIGN_EPI) { if (wr == 1) PG8_BAR; }
    }
    PG8_WAIT_V(0);
    if constexpr (!ALIGN_EPI) { if (wr == 0) PG8_BAR; }
    PG8_BAR;
    if constexpr (Epi::AFTER_DRAIN) { E.fused(acc, cur, wr, wc, fr, fq, lds, wid, lane); S.done(cur); }
#undef PG8_SA
#undef PG8_SB
#undef PG8_STAGE
#undef PG8_LDA
#undef PG8_LDB
#undef PG8_MMA
#undef PG8_WAIT_V
#undef PG8_WAIT_L
#undef PG8_BAR
#undef PG8_SCHED
}
}

#ifndef PG8_SP2
#define PG8_SP2 true
#endif
#ifndef PG8_ALIGN
#define PG8_ALIGN true
#endif
#define GAS __attribute__((address_space(1)))
#define LAS __attribute__((address_space(3)))
typedef unsigned short bf16;
typedef unsigned v4u __attribute__((ext_vector_type(4)));
typedef float f32x4 __attribute__((ext_vector_type(4)));
typedef short bf16x8 __attribute__((ext_vector_type(8)));
typedef GAS unsigned gu32;
typedef GAS unsigned long long gu64;
#define RLX_AGENT __ATOMIC_RELAXED, __HIP_MEMORY_SCOPE_AGENT
#define LDS_WAIT() asm volatile("s_waitcnt lgkmcnt(0)" ::: "memory")
#define VM_WAIT() asm volatile("s_waitcnt vmcnt(0)" ::: "memory")
__device__ __forceinline__ unsigned long long rt() { return __builtin_amdgcn_s_memrealtime(); }
__device__ __forceinline__ unsigned f2bf(float f) { unsigned u = __builtin_bit_cast(unsigned, f); return (u + 0x7fffu + ((u >> 16) & 1u)) >> 16; }
__device__ __forceinline__ unsigned pk2(float lo, float hi) { return f2bf(lo) | (f2bf(hi) << 16); }
#define XB_TMO      128
#define XB_XCNT(j)  (256  + 64 * (j))
#define XB_XSUB(j)  (1280 + 64 * (j))
#define XB_XGEN(j)  (2304 + 64 * (j))
#define XB_TOP      3328
#define XB_TOPGEN   3392
#define XCD_BAR_WORDS 3456
#define XB_SPIN_CAP (1u << 18)

__device__ __forceinline__ unsigned xb_ld(unsigned* p)              { return __hip_atomic_load(p, __ATOMIC_RELAXED, __HIP_MEMORY_SCOPE_AGENT); }
__device__ __forceinline__ unsigned xb_add(unsigned* p, unsigned v) { return __hip_atomic_fetch_add(p, v, __ATOMIC_RELAXED, __HIP_MEMORY_SCOPE_AGENT); }
__device__ __forceinline__ unsigned xb_xcc_id() { return (unsigned)__builtin_amdgcn_s_getreg((3 << 11) | 20) & 0xFu; }
#define XB_SPIN(cond, bar) do { unsigned _sp = 0; while (cond) { __builtin_amdgcn_s_sleep(1); \
    if ((++_sp & 255u) == 0u) { if (xb_ld(&(bar)[XB_TMO])) break; if (_sp > XB_SPIN_CAP) { atomicAdd(&(bar)[XB_TMO], 1u); break; } } } } while (0)

struct XcdBarrier {
    unsigned* bar; unsigned x;
    volatile LAS unsigned* st;
};

__device__ __forceinline__ XcdBarrier xcd_barrier_post(unsigned* bar, volatile LAS unsigned* st) {
    XcdBarrier b; b.bar = bar; b.x = xb_xcc_id(); b.st = st;
    if (threadIdx.x == 0) (void)xb_add(&bar[XB_XCNT(b.x)], 1u);
    return b;
}
__device__ __forceinline__ void xcd_barrier_complete(unsigned* bar, unsigned x, unsigned& nloc, unsigned& nx) {
    const unsigned G = gridDim.x * gridDim.y * gridDim.z;
    unsigned sum, cnt, mine, sp = 0u;
    for (;;) {
        sum = 0u; cnt = 0u; mine = 0u;
#pragma unroll
        for (unsigned j = 0; j < 16; ++j) { const unsigned c = xb_ld(&bar[XB_XCNT(j)]); sum += c; cnt += (c > 0u) ? 1u : 0u; mine = (j == x) ? c : mine; }
        if (sum == G) break;
        __builtin_amdgcn_s_sleep(1);
        if ((++sp & 255u) == 0u) { if (xb_ld(&bar[XB_TMO])) break; if (sp > XB_SPIN_CAP) { atomicAdd(&bar[XB_TMO], 1u); break; } }
    }
    nloc = mine > 0u ? mine : 1u; nx = cnt > 0u ? cnt : 1u;
}

__device__ __forceinline__ void xcd_barrier(const XcdBarrier& b) {
    asm volatile("s_waitcnt vmcnt(0)" ::: "memory");
    __syncthreads();
    if (threadIdx.x == 0) {
        unsigned* bar = b.bar;
        __builtin_amdgcn_s_waitcnt(0);
        unsigned nloc = b.st[0], nx = b.st[1];
        if (nloc == 0u) { xcd_barrier_complete(bar, b.x, nloc, nx); b.st[0] = nloc; b.st[1] = nx; }
        const unsigned old = xb_add(&bar[XB_XSUB(b.x)], 1u);
        const unsigned gen = old / nloc;
        if (old + 1u == (gen + 1u) * nloc) {
            __builtin_amdgcn_fence(__ATOMIC_RELEASE, "agent");
            asm volatile("s_waitcnt vmcnt(0)" ::: "memory");
            const unsigned og = xb_add(&bar[XB_TOP], 1u);
            const unsigned tg = og / nx;
            if (og + 1u == (tg + 1u) * nx) xb_add(&bar[XB_TOPGEN], 1u);
            else XB_SPIN(xb_ld(&bar[XB_TOPGEN]) == tg, bar);
            __builtin_amdgcn_fence(__ATOMIC_ACQUIRE, "agent");
            xb_add(&bar[XB_XGEN(b.x)], 1u);
            asm volatile("s_waitcnt vmcnt(0)" ::: "memory");
        } else {
            XB_SPIN(xb_ld(&bar[XB_XGEN(b.x)]) == gen, bar);
            __builtin_amdgcn_fence(__ATOMIC_ACQUIRE, "agent");
            asm volatile("s_waitcnt vmcnt(0)" ::: "memory");
        }
    }
    __syncthreads();
}
constexpr int NWAVES = 8;
#ifndef MK_N_LAUNCHES
#define MK_N_LAUNCHES 1
#endif
constexpr int N_PHASES = 8;
constexpr int N_LAUNCHES = MK_N_LAUNCHES;

constexpr size_t MiB = 1u << 20;
constexpr size_t WS_CTL = 0, CTL_ZERO_BYTES = 1 * MiB;
constexpr size_t WS_W0T = 2 * MiB;
constexpr size_t WS_WO0T = 9 * MiB;
constexpr size_t WS_W1T = 11 * MiB;
constexpr size_t WS_WO1T = 17 * MiB;
constexpr size_t WS_WSB = 19 * MiB;
constexpr size_t WS_KC = 20 * MiB, WS_VC = 36 * MiB;
constexpr size_t WS_XN = 52 * MiB;
constexpr size_t WS_ACT = 117 * MiB;
constexpr size_t WS_U = 117 * MiB, WS_SG = 182 * MiB;
constexpr size_t WS_A2 = 343 * MiB;
constexpr size_t WS_END = 408 * MiB;
static_assert(WS_XN + (size_t)MPAD * DM * 2 <= WS_ACT && WS_ACT + (size_t)MPAD * L0N * 2 <= WS_A2 && WS_A2 + (size_t)MPAD * DM * 2 <= WS_END, "d_ws map");
static_assert(WS_U + (size_t)MPAD * DM * 2 <= WS_SG && WS_SG + (size_t)MPAD * DM * 2 <= WS_A2, "d_ws overlay map");
constexpr int CW_BAR = 4096;
constexpr int CW_RS1 = 65536, CW_RS2 = 131072;
static_assert((CW_RS2 + MPAD) * 4 <= (int)CTL_ZERO_BYTES, "CTL words inside the memset region");

constexpr int RING_OFF = 0, RING_BYTES = 131072;
constexpr int LDSCTL_OFF = RING_BYTES, MISC_OFF = LDSCTL_OFF + 320;
constexpr int AUX_OFF = RING_BYTES + 1024;
constexpr int LDS_BYTES = 147456;
static_assert(AUX_OFF + 8192 <= LDS_BYTES, "LDS map");
typedef float f32x2 __attribute__((ext_vector_type(2)));
typedef unsigned u32x2 __attribute__((ext_vector_type(2)));
struct Frame {
    LAS unsigned char* lds;
    volatile LAS unsigned* MISC;
    gu32* ctl;
    int tid, lane, wave;
    int vcu, G;
    const float *xp, *xs, *ck, *cv, *cstate, *relb, *g0, *win0, *lq1, *lk1, *lq2, *lk2, *subg, *gvg, *gvb, *wsp, *bsp, *wout0, *g1, *win1, *wdw, *bdw, *clg, *clb, *wout1, *gf;
    float* out;
    bf16 *W0t, *Wo0t, *W1t, *Wo1t, *WSb, *KC, *VC, *XN, *ACT, *U, *SG, *A2;
    float *RS1, *RS2;
};

__device__ __forceinline__ float wave_sum(float v) {
#pragma unroll
    for (int o = 1; o < 64; o <<= 1) v += __shfl_xor(v, o);
    return v;
}
__device__ __forceinline__ void p0_transpose_item(const float* W, int K, int N, bf16* WT, int k0, int n0, int dst_n0, const float* kscale, LAS float* scr, int lane) {
#pragma unroll 8
    for (int i = 0; i < 32; ++i) { const int kk = 2 * i + (lane >> 5); float w = W[(size_t)(k0 + kk) * N + n0 + (lane & 31)]; if (kscale) w *= kscale[k0 + kk]; scr[kk * 33 + (lane & 31)] = w; }
    LDS_WAIT(); asm volatile("" ::: "memory");
    const int c = lane & 7;
#pragma unroll
    for (int j = 0; j < 4; ++j) { const int n = (lane >> 3) + 8 * j; const LAS float* s = scr + (8 * c) * 33 + n;
        v4u o; o.x = pk2(s[0 * 33], s[1 * 33]); o.y = pk2(s[2 * 33], s[3 * 33]); o.z = pk2(s[4 * 33], s[5 * 33]); o.w = pk2(s[6 * 33], s[7 * 33]);
        *(GAS v4u*)(WT + (size_t)(dst_n0 + n) * K + k0 + 8 * c) = o; }
    LDS_WAIT(); asm volatile("" ::: "memory");
}
__device__ __forceinline__ void rms_row_to_bf16(const float* xrow, const float* gain, bf16* orow, int lane) {
    const GAS f32x4* xr = (const GAS f32x4*)xrow + lane; const GAS f32x4* gr = (const GAS f32x4*)gain + lane;
    f32x4 v[4]; float s = 0.f;
#pragma unroll
    for (int j = 0; j < 4; ++j) { v[j] = xr[64 * j]; s += (v[j].x * v[j].x + v[j].y * v[j].y) + (v[j].z * v[j].z + v[j].w * v[j].w); }
    const float rs = 1.f / sqrtf(wave_sum(s) * (1.f / DM) + RMS_EPS);
    GAS unsigned long long* o8 = (GAS unsigned long long*)orow + lane;
#pragma unroll
    for (int j = 0; j < 4; ++j) { const f32x4 g = gr[64 * j]; const f32x4 y = v[j] * rs * g;
        o8[64 * j] = (unsigned long long)pk2(y.x, y.y) | ((unsigned long long)pk2(y.z, y.w) << 32); }
}
__device__ __forceinline__ void p0_prologue(Frame& F) {
    LAS float* scr = (LAS float*)(F.lds + RING_OFF + F.wave * 16384);
    const int gw = F.vcu * NWAVES + F.wave, NGW = F.G * NWAVES;
    constexpr int I_IN0 = 16 * (L0N / 32), I_O = 16 * 32, I_IN1 = 16 * (L1N / 32);
    constexpr int NITEMS = I_IN0 + I_O + I_IN1 + I_O;
    for (int it = gw; it < NITEMS; it += NGW) {
        int r = it;
        if (r < I_IN0) { const int nb = L0N / 32, k0 = 64 * (r / nb), n0 = 32 * (r % nb); p0_transpose_item(F.win0, DM, L0N, F.W0t, k0, n0, n0, nullptr, scr, F.lane); continue; } r -= I_IN0;
        if (r < I_O) { const int k0 = 64 * (r / 32), n0 = 32 * (r % 32); p0_transpose_item(F.wout0, DM, DM, F.Wo0t, k0, n0, n0, nullptr, scr, F.lane); continue; } r -= I_O;
        if (r < I_IN1) { const int nb = L1N / 32, k0 = 64 * (r / nb), n0 = 32 * (r % nb);
            int d0; if (n0 < 1024) d0 = 256 * (n0 >> 7) + (n0 & 127); else if (n0 < 2048) d0 = 256 * ((n0 - 1024) >> 7) + 128 + (n0 & 127); else d0 = n0;
            p0_transpose_item(F.win1, DM, L1N, F.W1t, k0, n0, d0, F.g1, scr, F.lane); continue; } r -= I_IN1;
        { const int k0 = 64 * (r / 32), n0 = 32 * (r % 32); p0_transpose_item(F.wout1, DM, DM, F.Wo1t, k0, n0, n0, nullptr, scr, F.lane); }
    }
    for (int m = gw; m < MPAD; m += NGW) {
        if (m < MV) rms_row_to_bf16(m < MP ? F.xp + (size_t)m * DM : F.xs + (size_t)(m - MP) * DM, F.g0, F.XN + (size_t)m * DM, F.lane);
        else { GAS unsigned long long* o8 = (GAS unsigned long long*)(F.XN + (size_t)m * DM) + F.lane;
#pragma unroll
            for (int j = 0; j < 4; ++j) o8[64 * j] = 0ull; }
    }
    { const long n8 = (long)SB * PAST * 512 / 8, gt = (long)F.vcu * (NWAVES * 64) + F.tid, NT = (long)F.G * NWAVES * 64;
      for (long i = gt; i < 2 * n8; i += NT) { const bool isk = i < n8; const long j = isk ? i : i - n8;
          const GAS f32x4* s = (const GAS f32x4*)((isk ? F.ck : F.cv) + j * 8); const f32x4 a = s[0], b = s[1];
          v4u o; o.x = pk2(a.x, a.y); o.y = pk2(a.z, a.w); o.z = pk2(b.x, b.y); o.w = pk2(b.z, b.w);
          *(GAS v4u*)((isk ? F.KC : F.VC) + j * 8) = o; }
      for (long i = gt; i < 4 * 128 * 128; i += NT) { const int ii = (int)(i >> 7) & 127, jj = (int)i & 127; F.WSb[i] = (bf16)f2bf(jj <= ii ? F.wsp[i] : 0.f); }
      for (long i = gt; i < (long)SB * 14 * DM; i += NT) { const int bs = (int)(i / (14 * DM)), rem = (int)(i % (14 * DM)); F.out[OFF_C1S + (size_t)bs * 30 * DM + rem] = F.cstate[(size_t)bs * 30 * DM + 16 * DM + rem]; }
    }
}
namespace att {
using bf16x8 = __attribute__((ext_vector_type(8))) short;
using s16x4  = __attribute__((ext_vector_type(4))) short;
using f32x16 = __attribute__((ext_vector_type(16))) float;
using u32x4  = __attribute__((ext_vector_type(4))) unsigned;
#define KSWZ(row, colB) ((row) * 256 + ((colB) ^ (((row) & 7) << 4)))
#define SBAR() __builtin_amdgcn_sched_barrier(0)
constexpr int LDS_V = 0, LDS_K = 32768, TILE_B = 16384, LDS_XCH = 0, XP = 132, LDS_SCR = 69632;
constexpr int BT_N = 320;
constexpr float THRL = 8.f;
__device__ __forceinline__ int crow(int r, int hi) { return (r & 3) + 8 * (r >> 2) + 4 * hi; }
__device__ __forceinline__ unsigned cvtpk(float lo, float hi) { unsigned r; asm volatile("v_cvt_pk_bf16_f32 %0, %1, %2" : "=v"(r) : "v"(lo), "v"(hi)); return r; }
__device__ __forceinline__ int v_st(int k, int c) { const int kk = (k & ~0xC) | ((k & 4) << 1) | ((k & 8) >> 1); return ((kk >> 3) * 4 + (c >> 5)) * 512 + ((kk & 7) * 32 + (c & 31)) * 2; }
__device__ __forceinline__ int v_rd_base(int lane) { return ((lane & 3) << 3) | (((lane >> 2) & 3) << 6) | (((lane >> 4) & 1) << 5) | (((lane >> 5) & 1) << 8); }
constexpr int v_rd_off(int d0, int ks, int half) { return d0 * 512 + ks * 4096 + half * 2048; }
template <int OFF> __device__ __forceinline__ s16x4 tr_read(int vb) { s16x4 r; asm volatile("ds_read_b64_tr_b16 %0, %1 offset:%2" : "=&v"(r) : "v"(vb), "i"(OFF) : "memory"); return r; }
template <int D0> __device__ __forceinline__ void pv_one(f32x16& od, int vb, bf16x8 pa0, bf16x8 pa1, bf16x8 pa2, bf16x8 pa3) {
    const s16x4 l0 = tr_read<v_rd_off(D0, 0, 0)>(vb), h0 = tr_read<v_rd_off(D0, 0, 1)>(vb), l1 = tr_read<v_rd_off(D0, 1, 0)>(vb), h1 = tr_read<v_rd_off(D0, 1, 1)>(vb);
    const s16x4 l2 = tr_read<v_rd_off(D0, 2, 0)>(vb), h2 = tr_read<v_rd_off(D0, 2, 1)>(vb), l3 = tr_read<v_rd_off(D0, 3, 0)>(vb), h3 = tr_read<v_rd_off(D0, 3, 1)>(vb);
    asm volatile("s_waitcnt lgkmcnt(0)" ::: "memory"); SBAR();
#define PK(L, H) (bf16x8){L[0], L[1], L[2], L[3], H[0], H[1], H[2], H[3]}
    od = __builtin_amdgcn_mfma_f32_32x32x16_bf16(pa0, PK(l0, h0), od, 0, 0, 0);
    od = __builtin_amdgcn_mfma_f32_32x32x16_bf16(pa1, PK(l1, h1), od, 0, 0, 0);
    od = __builtin_amdgcn_mfma_f32_32x32x16_bf16(pa2, PK(l2, h2), od, 0, 0, 0);
    od = __builtin_amdgcn_mfma_f32_32x32x16_bf16(pa3, PK(l3, h3), od, 0, 0, 0);
#undef PK
}
__device__ __forceinline__ float bf2f(unsigned short b) { return __uint_as_float((unsigned)b << 16); }

__device__ __forceinline__ void attn_setup(Frame& F) {
    LAS float* BT = (LAS float*)(F.lds + AUX_OFF);
    for (int i = F.tid; i < 4 * BT_N; i += NWAVES * 64) {
        const int h = i / BT_N, rel = (i % BT_N) - 256, n = rel < 0 ? -rel : rel;
        const int mag = n < 8 ? n : n < 12 ? 8 : n < 16 ? 9 : n < 23 ? 10 : n < 32 ? 11 : n < 46 ? 12 : n < 64 ? 13 : n < 91 ? 14 : 15;
        const int bucket = (rel > 0 ? 16 : 0) + mag;
        BT[i] = (F.relb[bucket * 4 + h] - F.relb[15 * 4 + h]) * LOG2E;
    }
    if (F.wave == 0) {
        const float a = wave_sum(F.lq1[F.lane] * F.lk1[F.lane]), b = wave_sum(F.lq2[F.lane] * F.lk2[F.lane]);
        if (F.lane == 0) *(LAS float*)(F.lds + AUX_OFF + 4 * BT_N * 4) = expf(a) - expf(b) + 0.2f;
    }
    __syncthreads();
}

template <bool SAMPLE>
__device__ __forceinline__ void attn_unit(Frame& F, int b, int h, int qt) {
    const int tid = F.tid, lane = F.lane, wid = F.wave, r32 = lane & 31, hi = lane >> 5;
    const int rg = wid & 3, c = wid >> 2;
    LAS unsigned char* ring = F.lds + RING_OFF;
    LAS float* scr = (LAS float*)(ring + LDS_SCR) + wid * 64;
    const LAS float* BT = (const LAS float*)(F.lds + AUX_OFF) + h * BT_N;
    const float lam = *(const LAS float*)(F.lds + AUX_OFF + 4 * BT_N * 4);
    const int qpos0 = SAMPLE ? PAST : 128 * qt;
    const size_t qrow0 = SAMPLE ? (size_t)MP + 16 * b : (size_t)b * SEQ + 128 * qt;
    const int NT = SAMPLE ? 33 : 2 * qt + 2;
    const int last_active = SAMPLE ? (rg == 0 ? 32 : -1) : 2 * qt + (rg >> 1);
    bf16x8 qr[4];
    { const bf16* Qw = F.ACT + (qrow0 + 32 * rg + r32) * L0N + h * 128 + 64 * c + hi * 8;
#pragma unroll
      for (int d0 = 0; d0 < 4; ++d0) qr[d0] = *(const GAS bf16x8*)(Qw + 16 * d0); }
    const int sr = tid >> 4, sc = (tid & 15) * 8, vst0 = v_st(sr, sc), vst1 = v_st(32 + sr, sc);
    const int vb0 = (int)(uintptr_t)(ring + LDS_V) + v_rd_base(lane);
    bf16x8 ks0, ks1, vs0, vs1;
#define SLOAD(j) do { const bf16 *kp_, *vp_; size_t pitch_; \
        if (SAMPLE && (j) < 32) { kp_ = F.KC + ((size_t)b * PAST + 64 * (j)) * 512 + h * 128 + sc; vp_ = F.VC + ((size_t)b * PAST + 64 * (j)) * 512 + h * 128 + sc; pitch_ = 512; } \
        else { const size_t r0_ = SAMPLE ? (size_t)MP + 16 * b : (size_t)b * SEQ + 64 * (j); kp_ = F.ACT + r0_ * L0N + 512 + h * 128 + sc; vp_ = kp_ + 512; pitch_ = L0N; } \
        ks0 = *(const GAS bf16x8*)(kp_ + (size_t)sr * pitch_); ks1 = *(const GAS bf16x8*)(kp_ + (size_t)(32 + sr) * pitch_); \
        vs0 = *(const GAS bf16x8*)(vp_ + (size_t)sr * pitch_); vs1 = *(const GAS bf16x8*)(vp_ + (size_t)(32 + sr) * pitch_); } while (0)
#define SWRITE(bf) do { *(LAS bf16x8*)(ring + LDS_V + (bf) * TILE_B + vst0) = vs0; *(LAS bf16x8*)(ring + LDS_V + (bf) * TILE_B + vst1) = vs1; \
        *(LAS bf16x8*)(ring + LDS_K + (bf) * TILE_B + KSWZ(sr, sc * 2)) = ks0; *(LAS bf16x8*)(ring + LDS_K + (bf) * TILE_B + KSWZ(32 + sr, sc * 2)) = ks1; } while (0)
    float m_reg = -1e30f, l_reg = 0.f; f32x16 o[4];
#pragma unroll
    for (int d = 0; d < 4; ++d) o[d] = f32x16{};
    SLOAD(0); VM_WAIT(); SWRITE(0); __syncthreads();
    for (int j = 0; j < NT; ++j) {
        const int buf = j & 1;
        if (j + 1 < NT) SLOAD(j + 1);
        if (j <= last_active) {
            f32x16 p0 = f32x16{}, p1 = f32x16{};
            const LAS unsigned char* Ks = ring + LDS_K + buf * TILE_B;
#pragma unroll
            for (int d0 = 0; d0 < 4; ++d0) { const int cb = (64 * c + d0 * 16 + hi * 8) * 2;
                const bf16x8 b0 = *(const LAS bf16x8*)(Ks + KSWZ(r32, cb)), b1 = *(const LAS bf16x8*)(Ks + KSWZ(32 + r32, cb));
                p0 = __builtin_amdgcn_mfma_f32_32x32x16_bf16(b0, qr[d0], p0, 0, 0, 0);
                p1 = __builtin_amdgcn_mfma_f32_32x32x16_bf16(b1, qr[d0], p1, 0, 0, 0); }
            if ((qpos0 + 32 * rg) - (64 * j + 63) < 91) {
                const LAS float* bt = BT + (64 * j - (qpos0 + 32 * rg + r32) + 256 + 4 * hi);
#pragma unroll
                for (int r = 0; r < 16; ++r) { const int kk = (r & 3) + 8 * (r >> 2); p0[r] += bt[kk]; p1[r] += bt[32 + kk]; }
            }
            if (SAMPLE && j == 32) {
#pragma unroll
                for (int r = 0; r < 16; ++r) { if (crow(r, hi) >= ST) p0[r] = -INFINITY; p1[r] = -INFINITY; }
            }
            float pmax = p0[0];
#pragma unroll
            for (int r = 1; r < 16; ++r) pmax = fmaxf(pmax, p0[r]);
#pragma unroll
            for (int r = 0; r < 16; ++r) pmax = fmaxf(pmax, p1[r]);
            { auto rr = __builtin_amdgcn_permlane32_swap(__float_as_uint(pmax), __float_as_uint(pmax), false, false); pmax = fmaxf(__uint_as_float(rr[0]), __uint_as_float(rr[1])); }
            float alpha = 1.f;
            if (!__all(pmax - m_reg <= THRL)) { const float mn = fmaxf(m_reg, pmax); alpha = __builtin_amdgcn_exp2f(m_reg - mn); m_reg = mn;
                if (hi == 0) scr[r32] = alpha; LDS_WAIT();
#pragma unroll
                for (int d = 0; d < 4; ++d)
#pragma unroll
                    for (int r = 0; r < 16; ++r) o[d][r] *= scr[crow(r, hi)];
            }
            float ps = 0.f;
#pragma unroll
            for (int r = 0; r < 16; ++r) { p0[r] = __builtin_amdgcn_exp2f(p0[r] - m_reg); p1[r] = __builtin_amdgcn_exp2f(p1[r] - m_reg); ps += p0[r] + p1[r]; }
            { auto rr = __builtin_amdgcn_permlane32_swap(__float_as_uint(ps), __float_as_uint(ps), false, false); ps = __uint_as_float(rr[0]) + __uint_as_float(rr[1]); }
            l_reg = l_reg * alpha + ps;
            bf16x8 pa0, pa1, pa2, pa3;
#define PK4(P, BASE, OUT) do { unsigned a0 = cvtpk(P[BASE + 0], P[BASE + 1]), a1 = cvtpk(P[BASE + 2], P[BASE + 3]);   \
    unsigned b0_ = cvtpk(P[BASE + 4], P[BASE + 5]), b1_ = cvtpk(P[BASE + 6], P[BASE + 7]);                              \
    auto r0 = __builtin_amdgcn_permlane32_swap(a0, b0_, false, false); auto r1 = __builtin_amdgcn_permlane32_swap(a1, b1_, false, false); \
    u32x4 w = {r0[0], r1[0], r0[1], r1[1]}; OUT = *reinterpret_cast<bf16x8*>(&w); } while (0)
            PK4(p0, 0, pa0); PK4(p0, 8, pa1); PK4(p1, 0, pa2); PK4(p1, 8, pa3);
#undef PK4
            const int vb = vb0 + buf * TILE_B;
            pv_one<0>(o[0], vb, pa0, pa1, pa2, pa3); pv_one<1>(o[1], vb, pa0, pa1, pa2, pa3); pv_one<2>(o[2], vb, pa0, pa1, pa2, pa3); pv_one<3>(o[3], vb, pa0, pa1, pa2, pa3);
        }
        if (j + 1 < NT) { VM_WAIT(); SWRITE((j + 1) & 1); }
        __syncthreads();
    }
#undef SLOAD
#undef SWRITE
    const bool active = last_active >= 0;
    LAS float* X = (LAS float*)(ring + LDS_XCH) + rg * (32 * XP);
    float rli[16];
    if (active) { if (hi == 0) scr[r32] = l_reg; LDS_WAIT();
#pragma unroll
        for (int r = 0; r < 16; ++r) rli[r] = __builtin_amdgcn_rcpf(scr[crow(r, hi)]); }
    if (active && c == 1) {
#pragma unroll
        for (int r = 0; r < 16; ++r)
#pragma unroll
            for (int d = 0; d < 4; ++d) X[crow(r, hi) * XP + 32 * d + r32] = lam * o[d][r] * rli[r];
    }
    __syncthreads();
    if (active && c == 0) {
#pragma unroll
        for (int r = 0; r < 16; ++r)
#pragma unroll
            for (int d = 0; d < 4; ++d) { const int ix = crow(r, hi) * XP + 32 * d + r32; X[ix] = o[d][r] * rli[r] - X[ix]; }
        LDS_WAIT();
#pragma unroll
        for (int it = 0; it < 4; ++it) {
            const int row = it * 8 + (lane >> 3), col = (lane & 7) * 16;
            f32x4 v[4]; float ss = 0.f;
#pragma unroll
            for (int k = 0; k < 4; ++k) { v[k] = *(const LAS f32x4*)(X + row * XP + col + 4 * k); ss += (v[k].x * v[k].x + v[k].y * v[k].y) + (v[k].z * v[k].z + v[k].w * v[k].w); }
            ss += __shfl_xor(ss, 1); ss += __shfl_xor(ss, 2); ss += __shfl_xor(ss, 4);
            const float rstd = (1.0f - 0.2f) / sqrtf(ss * (1.f / 128.f) + RMS_EPS);
            const size_t R = qrow0 + 32 * rg + row;
            if (!SAMPLE || row < ST) {
                const GAS bf16x8* gp = (const GAS bf16x8*)(F.ACT + R * L0N + 1536 + h * 128 + col); const bf16x8 g0 = gp[0], g1 = gp[1];
                const GAS f32x4* sg = (const GAS f32x4*)(F.subg + col);
                float y[16];
#pragma unroll
                for (int k = 0; k < 4; ++k) { const f32x4 s4 = sg[k];
#pragma unroll
                    for (int e = 0; e < 4; ++e) { const int ix = 4 * k + e; const float ga = bf2f((unsigned short)(ix < 8 ? g0[ix] : g1[ix - 8])); y[ix] = v[k][e] * rstd * s4[e] * ga; } }
                v4u w0, w1; w0.x = pk2(y[0], y[1]); w0.y = pk2(y[2], y[3]); w0.z = pk2(y[4], y[5]); w0.w = pk2(y[6], y[7]); w1.x = pk2(y[8], y[9]); w1.y = pk2(y[10], y[11]); w1.z = pk2(y[12], y[13]); w1.w = pk2(y[14], y[15]);
                GAS v4u* op = (GAS v4u*)(F.A2 + R * DM + h * 128 + col); op[0] = w0; op[1] = w1;
            }
        }
    }
    __syncthreads();
}
#undef KSWZ
#undef SBAR
}
namespace gate {
using bf16x8 = __attribute__((ext_vector_type(8))) short;
using f32x16 = __attribute__((ext_vector_type(16))) float;
constexpr int ZP = 136, LDS_ZT = 0, LDS_D = 36864, DP = 132;
__device__ __forceinline__ int crow(int r, int hi) { return (r & 3) + 8 * (r >> 2) + 4 * hi; }
__device__ __forceinline__ float bf2f(unsigned short b) { return __uint_as_float((unsigned)b << 16); }

__device__ __forceinline__ void gate_unit(Frame& F, size_t R0, int T, int g, float* gvs) {
    const int tid = F.tid, lane = F.lane, wid = F.wave;
    LAS unsigned char* ring = F.lds + RING_OFF;
    LAS unsigned short* ZT = (LAS unsigned short*)(ring + LDS_ZT);
    LAS float* Dm = (LAS float*)(ring + LDS_D);
    { const int j = tid >> 2, c0 = (tid & 3) * 32;
      float x[32];
      if (j < T) { const GAS bf16x8* p = (const GAS bf16x8*)(F.ACT + (R0 + j) * L0N + 2560 + g * 128 + c0);
#pragma unroll
          for (int k = 0; k < 4; ++k) { const bf16x8 v = p[k];
#pragma unroll
              for (int e = 0; e < 8; ++e) x[8 * k + e] = bf2f((unsigned short)v[e]); } }
      else {
#pragma unroll
          for (int e = 0; e < 32; ++e) x[e] = 0.f; }
      float s = 0.f;
#pragma unroll
      for (int e = 0; e < 32; ++e) s += x[e];
      s += __shfl_xor(s, 1); s += __shfl_xor(s, 2);
      const float mean = s * (1.f / 128.f); float q = 0.f;
#pragma unroll
      for (int e = 0; e < 32; ++e) { x[e] -= mean; q += x[e] * x[e]; }
      q += __shfl_xor(q, 1); q += __shfl_xor(q, 2);
      const float rstd = 1.f / sqrtf(q * (1.f / 128.f) + LN_EPS);
      const float* lg = F.gvg + g * 128 + c0; const float* lb = F.gvb + g * 128 + c0;
#pragma unroll
      for (int e = 0; e < 32; ++e) { float y = (j < T) ? x[e] * rstd * lg[e] + lb[e] : 0.f; x[e] = y; ZT[(c0 + e) * ZP + j] = (unsigned short)f2bf(y); }
      if (gvs && j < T) { GAS f32x4* d = (GAS f32x4*)(gvs + (size_t)j * 512 + g * 128 + c0);
#pragma unroll
          for (int k = 0; k < 8; ++k) d[k] = (f32x4){x[4 * k], x[4 * k + 1], x[4 * k + 2], x[4 * k + 3]}; }
    }
    __syncthreads();
    { const int ib = wid >> 1, ch = wid & 1, r32 = lane & 31, hi = lane >> 5;
      f32x16 acc0 = f32x16{}, acc1 = f32x16{};
      const bf16* wrow = F.WSb + ((size_t)g * 128 + 32 * ib + r32) * 128 + 8 * hi;
      const LAS unsigned short* z0 = ZT + (32 * (2 * ch) + r32) * ZP + 8 * hi; const LAS unsigned short* z1 = z0 + 32 * ZP;
      const int nks = 2 * (ib + 1);
      for (int ks = 0; ks < nks; ++ks) {
          const bf16x8 a = *(const GAS bf16x8*)(wrow + 16 * ks);
          const bf16x8 b0 = *(const LAS bf16x8*)(z0 + 16 * ks), b1 = *(const LAS bf16x8*)(z1 + 16 * ks);
          acc0 = __builtin_amdgcn_mfma_f32_32x32x16_bf16(a, b0, acc0, 0, 0, 0);
          acc1 = __builtin_amdgcn_mfma_f32_32x32x16_bf16(a, b1, acc1, 0, 0, 0);
      }
#pragma unroll
      for (int r = 0; r < 16; ++r) { const int i = 32 * ib + crow(r, hi); Dm[i * DP + 32 * (2 * ch) + r32] = acc0[r]; Dm[i * DP + 32 * (2 * ch + 1) + r32] = acc1[r]; }
    }
    __syncthreads();
#pragma unroll
    for (int it = 0; it < 4; ++it) { const int p = tid + 512 * it, i = p >> 4, c8 = (p & 15) * 8;
        if (i < T) {
            const f32x4 d0 = *(const LAS f32x4*)(Dm + i * DP + c8), d1 = *(const LAS f32x4*)(Dm + i * DP + c8 + 4);
            const bf16* arow = F.ACT + (R0 + i) * L0N + g * 128 + c8;
            const bf16x8 zu = *(const GAS bf16x8*)(arow + 2048), sg = *(const GAS bf16x8*)(arow + 3072);
            const float bs = F.bsp[g * 128 + i];
            float y[8];
#pragma unroll
            for (int e = 0; e < 8; ++e) y[e] = bf2f((unsigned short)zu[e]) * ((e < 4 ? d0[e] : d1[e - 4]) + bs) * bf2f((unsigned short)sg[e]);
            v4u w; w.x = pk2(y[0], y[1]); w.y = pk2(y[2], y[3]); w.z = pk2(y[4], y[5]); w.w = pk2(y[6], y[7]);
            *(GAS v4u*)(F.A2 + (R0 + i) * DM + 512 + g * 128 + c8) = w;
        } }
}
}
namespace cv {
__device__ __forceinline__ float bf2f(unsigned short b) { return __uint_as_float((unsigned)b << 16); }
__device__ __forceinline__ void conv_segment(Frame& F, size_t R0, int t0, int L, const float* hist) {
    const int tid = F.tid, lane = F.lane, wid = F.wave, ch = 2 * tid;
    LAS float* tile = (LAS float*)(F.lds + RING_OFF);
    f32x2 w[CW];
#pragma unroll
    for (int j = 0; j < CW; ++j) w[j] = *(const GAS f32x2*)(F.wdw + (size_t)j * DM + ch);
    const f32x2 bd = *(const GAS f32x2*)(F.bdw + ch);
    f32x2 win[38];
#pragma unroll
    for (int i = 0; i < 30; ++i) { const int t = t0 - 30 + i;
        if (t >= 0) { const unsigned v = *(const GAS unsigned*)(F.U + (R0 + t) * DM + ch); win[i] = (f32x2){bf2f((unsigned short)(v & 0xffffu)), bf2f((unsigned short)(v >> 16))}; }
        else if (hist) win[i] = *(const GAS f32x2*)(hist + (size_t)(30 + t) * DM + ch);
        else win[i] = (f32x2){0.f, 0.f}; }
    for (int tb = 0; tb < L; tb += 8) {
#pragma unroll
        for (int o = 0; o < 8; ++o) { const unsigned v = *(const GAS unsigned*)(F.U + (R0 + t0 + tb + o) * DM + ch); win[30 + o] = (f32x2){bf2f((unsigned short)(v & 0xffffu)), bf2f((unsigned short)(v >> 16))}; }
#pragma unroll
        for (int o = 0; o < 8; ++o) { f32x2 a = bd;
#pragma unroll
            for (int j = 0; j < CW; ++j) a = w[j] * win[o + j] + a;
            *(LAS f32x2*)(tile + ((tb & 31) + o) * DM + ch) = a; }
#pragma unroll
        for (int i = 0; i < 30; ++i) win[i] = win[i + 8];
        if (((tb + 8) & 31) == 0 || tb + 8 >= L) {
            const int tbase = tb & ~31, cnt = tb + 8 - tbase;
            __syncthreads();
            for (int tk = wid; tk < cnt; tk += NWAVES) {
                const LAS f32x4* row = (const LAS f32x4*)(tile + tk * DM) + lane;
                f32x4 v[4]; float s = 0.f;
#pragma unroll
                for (int k = 0; k < 4; ++k) { v[k] = row[64 * k]; s += (v[k].x + v[k].y) + (v[k].z + v[k].w); }
                const float mean = wave_sum(s) * (1.f / DM); float q = 0.f;
#pragma unroll
                for (int k = 0; k < 4; ++k) { v[k] = v[k] - mean; q += (v[k].x * v[k].x + v[k].y * v[k].y) + (v[k].z * v[k].z + v[k].w * v[k].w); }
                const float rstd = 1.f / sqrtf(wave_sum(q) * (1.f / DM) + LN_EPS);
                const size_t R = R0 + t0 + tbase + tk;
#pragma unroll
                for (int k = 0; k < 4; ++k) { const int c4 = 4 * (lane + 64 * k);
                    const f32x4 lg = *(const GAS f32x4*)(F.clg + c4), lb = *(const GAS f32x4*)(F.clb + c4);
                    const u32x2 sg = *(const GAS u32x2*)(F.SG + R * DM + c4);
                    f32x4 y = v[k] * rstd * lg + lb;
                    const float g0 = bf2f((unsigned short)(sg.x & 0xffffu)), g1 = bf2f((unsigned short)(sg.x >> 16)), g2 = bf2f((unsigned short)(sg.y & 0xffffu)), g3 = bf2f((unsigned short)(sg.y >> 16));
                    y.x = pg8::silu_f(y.x) * g0; y.y = pg8::silu_f(y.y) * g1; y.z = pg8::silu_f(y.z) * g2; y.w = pg8::silu_f(y.w) * g3;
                    u32x2 o; o.x = pk2(y.x, y.y); o.y = pk2(y.z, y.w);
                    *(GAS u32x2*)(F.A2 + R * DM + c4) = o; }
            }
            __syncthreads();
        }
    }
}
}
struct Args { const float* in[26]; float* out; unsigned char* ws; int ph_lo, ph_hi; };
static_assert(sizeof(Args) == 28 * 8 + 8, "Args has no padding");
__global__ void __launch_bounds__(NWAVES * 64, 2) mega_fwd(Args args) {
    extern __shared__ __attribute__((aligned(16))) unsigned char lds[];
    Frame F;
    F.lds = (LAS unsigned char*)lds;
    F.MISC = (volatile LAS unsigned*)(F.lds + MISC_OFF);
    F.tid = threadIdx.x; F.lane = F.tid & 63; F.wave = __builtin_amdgcn_readfirstlane(F.tid >> 6);
    F.G = gridDim.x; { const int bx = blockIdx.x; F.vcu = (F.G % 8 == 0) ? (bx % 8) * (F.G / 8) + bx / 8 : bx; }
    unsigned char* ws = args.ws;
    F.ctl = (gu32*)(ws + WS_CTL);
    F.xp = args.in[0]; F.xs = args.in[1]; F.ck = args.in[2]; F.cv = args.in[3]; F.cstate = args.in[4]; F.relb = args.in[5]; F.g0 = args.in[6]; F.win0 = args.in[7];
    F.lq1 = args.in[8]; F.lk1 = args.in[9]; F.lq2 = args.in[10]; F.lk2 = args.in[11]; F.subg = args.in[12]; F.gvg = args.in[13]; F.gvb = args.in[14]; F.wsp = args.in[15]; F.bsp = args.in[16];
    F.wout0 = args.in[17]; F.g1 = args.in[18]; F.win1 = args.in[19]; F.wdw = args.in[20]; F.bdw = args.in[21]; F.clg = args.in[22]; F.clb = args.in[23]; F.wout1 = args.in[24]; F.gf = args.in[25];
    F.out = args.out;
    F.W0t = (bf16*)(ws + WS_W0T); F.Wo0t = (bf16*)(ws + WS_WO0T); F.W1t = (bf16*)(ws + WS_W1T); F.Wo1t = (bf16*)(ws + WS_WO1T); F.WSb = (bf16*)(ws + WS_WSB);
    F.KC = (bf16*)(ws + WS_KC); F.VC = (bf16*)(ws + WS_VC); F.XN = (bf16*)(ws + WS_XN); F.ACT = (bf16*)(ws + WS_ACT); F.U = (bf16*)(ws + WS_U); F.SG = (bf16*)(ws + WS_SG); F.A2 = (bf16*)(ws + WS_A2);
    F.RS1 = (float*)(ws + WS_CTL) + CW_RS1; F.RS2 = (float*)(ws + WS_CTL) + CW_RS2;
    for (int u = F.tid; u < (AUX_OFF - LDSCTL_OFF) / 4; u += NWAVES * 64) ((LAS unsigned*)(F.lds + LDSCTL_OFF))[u] = 0u;
    __syncthreads();
    XcdBarrier bar; bar.bar = (unsigned*)(F.ctl + CW_BAR); bar.x = 0; bar.st = nullptr;
    if (N_LAUNCHES == 1) bar = xcd_barrier_post((unsigned*)(F.ctl + CW_BAR), F.MISC + 8);
#define GRID_BAR() do { if (N_LAUNCHES == 1) xcd_barrier(bar); } while (0)
    const int lo = args.ph_lo, hi = args.ph_hi;
#define IN(k) (lo <= (k) && (k) < hi)
#define BOTH(k) (IN(k) && IN((k) + 1))

    if (IN(0)) { p0_prologue(F); if (BOTH(0)) GRID_BAR(); }

    if (IN(1)) {
        pg8::Gemm g{F.XN, F.W0t, MPAD, L0N, DM}; pg8::StaticOrder S; S.init(MPAD, L0N, F.G, (int)blockIdx.x);
        pg8::EpiL0In E{F.ACT, F.out};
        pg8::gemm_phase<pg8::EpiL0In, pg8::StaticOrder, PG8_ALIGN, PG8_SP2>(F.lds + RING_OFF, g, S, E);
        if (BOTH(1)) GRID_BAR();
    }

    if (IN(2)) {
        att::attn_setup(F);
        { const int bh = F.vcu >> 2, s = F.vcu & 3;
          if (F.G == 256) {
              for (int i = 0; i < 4; ++i) { const int qt = (i == 0) ? s : (i == 1) ? 7 - s : (i == 2) ? 8 + s : 15 - s; att::attn_unit<false>(F, bh >> 2, bh & 3, qt); }
          } else {
              for (int u = F.vcu; u < NB * 4 * 16; u += F.G) att::attn_unit<false>(F, u >> 6, (u >> 4) & 3, u & 15);
          }
          for (int u = F.vcu; u < SB * 4; u += F.G) att::attn_unit<true>(F, u >> 2, u & 3, 0);
        }
        for (int u = F.vcu; u < NB * 16 * 4; u += F.G) { const int sq = u >> 6, n = (u >> 2) & 15, g = u & 3; gate::gate_unit(F, (size_t)sq * SEQ + 128 * n, 128, g, nullptr); }
        for (int u = F.vcu; u < SB * 4; u += F.G) { const int bs = u >> 2, g = u & 3; gate::gate_unit(F, (size_t)MP + ST * bs, ST, g, F.out + OFF_GVS + (size_t)bs * ST * 512); }
        if (BOTH(2)) GRID_BAR();
    }

    if (IN(3)) {
        pg8::Gemm g{F.A2, F.Wo0t, MPAD, DM, DM}; pg8::StaticOrder S; S.init(MPAD, DM, F.G, (int)blockIdx.x);
        pg8::EpiRes<true> E{F.xp, F.xs, F.out, F.XN, F.RS1};
        pg8::gemm_phase<pg8::EpiRes<true>, pg8::StaticOrder, PG8_ALIGN, PG8_SP2>(F.lds + RING_OFF, g, S, E);
        if (BOTH(3)) GRID_BAR();
    }

    if (IN(4)) {
        pg8::Gemm g{F.XN, F.W1t, MPAD, L1N, DM}; pg8::StaticOrder S; S.init(MPAD, L1N, F.G, (int)blockIdx.x);
        pg8::EpiL1In E{F.RS1, F.U, F.SG, F.out};
        pg8::gemm_phase<pg8::EpiL1In, pg8::StaticOrder, PG8_ALIGN, PG8_SP2>(F.lds + RING_OFF, g, S, E);
        if (BOTH(4)) GRID_BAR();
    }

    if (IN(5)) {
        for (int sgm = F.vcu; sgm < NB * 16; sgm += F.G) cv::conv_segment(F, (size_t)(sgm >> 4) * SEQ, (sgm & 15) * 128, 128, nullptr);
        for (int bs = F.vcu; bs < SB; bs += F.G) cv::conv_segment(F, (size_t)MP + ST * bs, 0, ST, F.cstate + (size_t)bs * 30 * DM);
        if (BOTH(5)) GRID_BAR();
    }

    if (IN(6)) {
        pg8::Gemm g{F.A2, F.Wo1t, MPAD, DM, DM}; pg8::StaticOrder S; S.init(MPAD, DM, F.G, (int)blockIdx.x);
        pg8::EpiRes<false> E{F.xp, F.xs, F.out, F.XN, F.RS2};
        pg8::gemm_phase<pg8::EpiRes<false>, pg8::StaticOrder, PG8_ALIGN, PG8_SP2>(F.lds + RING_OFF, g, S, E);
        if (BOTH(6)) GRID_BAR();
    }

    if (IN(7)) {
        const int gw = F.vcu * NWAVES + F.wave, NGW = F.G * NWAVES;
        for (int m = gw; m < MV; m += NGW) {
            float* yrow = m < MP ? F.out + OFF_YP + (size_t)m * DM : F.out + OFF_YS + (size_t)(m - MP) * DM;
            const float rs = 1.f / sqrtf(F.RS2[m] * (1.f / DM) + RMS_EPS);
            GAS f32x4* yr = (GAS f32x4*)yrow + F.lane; const GAS f32x4* gr = (const GAS f32x4*)F.gf + F.lane;
#pragma unroll
            for (int j = 0; j < 4; ++j) yr[64 * j] = yr[64 * j] * rs * gr[64 * j];
        }
    }
#undef IN
#undef BOTH
#undef GRID_BAR
}

extern "C" void kernel_launch(void* const* d_in, const int* in_sizes, int n_in, void* d_out, int out_size, void* d_ws, size_t ws_size, hipStream_t stream) {
    static int grid = 0;
    if (grid == 0) {
        if (n_in != 26 || in_sizes[0] != MP * DM || (size_t)out_size != OUT_TOTAL || ws_size < WS_END) {
            fprintf(stderr, "kernel_launch: shape mismatch: n_in %d in0 %d out %d ws %zu (need %zu); nothing launched\n", n_in, n_in > 0 ? in_sizes[0] : -1, out_size, ws_size, (size_t)WS_END); grid = -1; return; }
        int dev = 0, cus = 0, per_cu = 0;
        if (hipGetDevice(&dev) != hipSuccess || hipDeviceGetAttribute(&cus, hipDeviceAttributeMultiprocessorCount, dev) != hipSuccess) { fprintf(stderr, "kernel_launch: device query failed\n"); grid = -1; return; }
        if (hipFuncSetAttribute((const void*)mega_fwd, hipFuncAttributeMaxDynamicSharedMemorySize, LDS_BYTES) != hipSuccess) { fprintf(stderr, "kernel_launch: hipFuncSetAttribute failed\n"); grid = -1; return; }
        if (hipOccupancyMaxActiveBlocksPerMultiprocessor(&per_cu, (const void*)mega_fwd, NWAVES * 64, LDS_BYTES) != hipSuccess || per_cu < 1)
            fprintf(stderr, "kernel_launch: note: occupancy query reports %d workgroups per CU\n", per_cu);
        (void)hipGetLastError();
        grid = cus;
    }
    if (grid < 0) return;
    if (hipMemsetAsync((char*)d_ws + WS_CTL, 0, CTL_ZERO_BYTES, stream) != hipSuccess) { fprintf(stderr, "kernel_launch: hipMemsetAsync failed\n"); return; }
    Args a{};
    for (int i = 0; i < 26; ++i) a.in[i] = (const float*)d_in[i];
    a.out = (float*)d_out; a.ws = (unsigned char*)d_ws;
    for (int li = 0; li < N_LAUNCHES; ++li) {
        a.ph_lo = (N_LAUNCHES == 1) ? 0 : li; a.ph_hi = (N_LAUNCHES == 1) ? N_PHASES : li + 1;
        hipLaunchKernelGGL(mega_fwd, dim3(grid), dim3(NWAVES * 64), LDS_BYTES, stream, a);
        const hipError_t le = hipPeekAtLastError();
        if (le != hipSuccess) { fprintf(stderr, "kernel_launch: launch %d failed: %s\n", li, hipGetErrorName(le)); break; }
    }
}
```

```cpp
#include <hip/hip_runtime.h>
#include <cstdio>
#include <cstdint>

constexpr int DM = 1024;
constexpr int SEQ = 2048, NB = 16;
constexpr int SB = 8, ST = 16, PAST = 2048;
constexpr int MP = NB * SEQ;
constexpr int MS = SB * ST;
constexpr int MV = MP + MS;
constexpr int MPAD = 33024;
constexpr int L0N = 3584, L1N = 3072;
constexpr int CW = 31;
constexpr float RMS_EPS = 1e-6f, LN_EPS = 1e-5f;
constexpr float C2 = 0.125f * 1.4426950408889634f;
constexpr float LOG2E = 1.4426950408889634f;
constexpr size_t OFF_YP = 0, OFF_YS = (size_t)MP * DM, OFF_K0P = OFF_YS + (size_t)MS * DM, OFF_V0P = OFF_K0P + (size_t)MP * 512,
                 OFF_C1P = OFF_V0P + (size_t)MP * 512, OFF_K0S = OFF_C1P + (size_t)NB * 30 * DM, OFF_V0S = OFF_K0S + (size_t)MS * 512,
                 OFF_GVS = OFF_V0S + (size_t)MS * 512, OFF_C1S = OFF_GVS + (size_t)MS * 512, OUT_TOTAL = OFF_C1S + (size_t)SB * 30 * DM;
static_assert(OUT_TOTAL == 68173824, "output size");
namespace pg8 {
#define PG8_LAS __attribute__((address_space(3)))
typedef unsigned short bf16_t;
typedef short bf16x8 __attribute__((ext_vector_type(8)));
typedef float f32x4 __attribute__((ext_vector_type(4)));
typedef unsigned u32x4 __attribute__((ext_vector_type(4)));
constexpr int BM = 256, BK = 64, HALF = 128, HTB = HALF * BK * 2  , STAGE_BYTES = 8 * HTB, NXCD = 8, WGM = 8;

__host__ __device__ __forceinline__ int lds_byte(int r, int c) { const int st = (r >> 4) * 2 + (c >> 5), rr = r & 15, cc = c & 31, ob = rr * 64 + cc * 2; return st * 1024 + (ob ^ (((ob >> 9) & 1) << 5)); }
__host__ __device__ __forceinline__ void stage_rc(int b, int& R, int& C) { const int st = b / 1024, sb = b % 1024, swz = sb ^ (((sb >> 9) & 1) << 5); R = (st >> 1) * 16 + swz / 64; C = (st & 1) * 32 + (swz % 64) / 2; }
__host__ __device__ __forceinline__ int perm32(int rho) { const int n = rho >> 4, i = rho & 15; return 8 * (i >> 2) + 4 * n + (i & 3); }

struct Unit { int pm, pn; };
struct Gemm { const bf16_t* A; const bf16_t* Bt; int M, N, K; };

struct StaticOrder {
    int nM, nN, nwg, G, c;
    __host__ __device__ void init(int M, int N, int G_, int c_) { nM = M / BM; nN = N / BM; nwg = nM * nN; G = G_; c = c_; }
    __host__ __device__ bool next(int i, Unit& u) const {
        const long L = (long)i * G + c; if (L >= nwg) return false;
        int wgid = (int)L; { const int q = nwg / NXCD, r = nwg % NXCD, xcd = wgid % NXCD, off = wgid / NXCD; wgid = (xcd < r ? xcd * (q + 1) : r * (q + 1) + (xcd - r) * q) + off; }
        const int nig = WGM * nN, gid = wgid / nig, fm = gid * WGM, gsz = (nM - fm) < WGM ? (nM - fm) : WGM;
        u.pm = fm + ((wgid % nig) % gsz); u.pn = (wgid % nig) / gsz; return true;
    }
    __device__ __forceinline__ void a_ready(const Unit&) const {}
    __device__ __forceinline__ void done(const Unit&) const {}
};

__device__ __forceinline__ unsigned cvt_pk_bf16(float lo, float hi) { unsigned r; asm volatile("v_cvt_pk_bf16_f32 %0, %1, %2" : "=v"(r) : "v"(lo), "v"(hi)); return r; }
__device__ __forceinline__ float sigmoid_f(float x) { return __builtin_amdgcn_rcpf(1.f + __builtin_amdgcn_exp2f(-LOG2E * x)); }
__device__ __forceinline__ float silu_f(float x) { return x * sigmoid_f(x); }
__device__ __forceinline__ float gelu_f(float x) { const float t = x * (-2.302208198f - 0.1029432397f * x * x); return x * __builtin_amdgcn_rcpf(1.f + __builtin_amdgcn_exp2f(t)); }
__device__ __forceinline__ u32x4 pack8(const f32x4& a, const f32x4& b) { u32x4 w; w.x = cvt_pk_bf16(a[0], a[1]); w.y = cvt_pk_bf16(a[2], a[3]); w.z = cvt_pk_bf16(b[0], b[1]); w.w = cvt_pk_bf16(b[2], b[3]); return w; }

struct EpiL0In {
    static constexpr bool PERM = true, AFTER_DRAIN = false;
    bf16_t* act; float* out;
    template <int KIND> __device__ __forceinline__ void body(const f32x4 (&acc)[2][2][4][2], const Unit& u, int wr, int wc, int fr, int fq) const {
        const int row0 = u.pm * BM + wr * 64 + fr, col0 = u.pn * BM + wc * 32 + 8 * fq;
#pragma unroll
        for (int ai = 0; ai < 2; ++ai)
#pragma unroll
            for (int m = 0; m < 4; ++m) { const int R = row0 + ai * HALF + m * 16; bf16_t* rowp = act + (size_t)R * L0N + col0;
#pragma unroll
                for (int bj = 0; bj < 2; ++bj) { f32x4 v0 = acc[ai][bj][m][0], v1 = acc[ai][bj][m][1];
                    if (KIND == 0) { v0 = v0 * C2; v1 = v1 * C2; }
                    if (KIND == 1) {
                        const int kv = (u.pn >> 1) - 1, kc = col0 + bj * HALF - 512 * (kv + 1);
                        float* d = out + (kv ? OFF_V0P : OFF_K0P) + (size_t)R * 512 + kc; *(f32x4*)d = v0; *(f32x4*)(d + 4) = v1;
                    }
                    if (KIND == 2) {
#pragma unroll
                        for (int j = 0; j < 4; ++j) { v0[j] = silu_f(v0[j]); v1[j] = silu_f(v1[j]); } }
                    if (KIND == 3) {
#pragma unroll
                        for (int j = 0; j < 4; ++j) { v0[j] = gelu_f(v0[j]); v1[j] = gelu_f(v1[j]); } }
                    *(u32x4*)(rowp + bj * HALF) = pack8(v0, v1); } }
    }
    __device__ __forceinline__ void operator()(const f32x4 (&acc)[2][2][4][2], const Unit& u, int wr, int wc, int fr, int fq) const {
        const int kind = u.pn >> 1;
        if (kind == 0) body<0>(acc, u, wr, wc, fr, fq);
        else if (kind == 1 || kind == 2) body<1>(acc, u, wr, wc, fr, fq);
        else if (kind == 3 || kind == 6) body<2>(acc, u, wr, wc, fr, fq);
        else body<3>(acc, u, wr, wc, fr, fq);
    }
};

template <bool FIRST> struct EpiRes {
    static constexpr bool PERM = true, AFTER_DRAIN = false;
    const float* xp; const float* xs; float* out; bf16_t* yb; float* rss;
    __device__ __forceinline__ void operator()(const f32x4 (&acc)[2][2][4][2], const Unit& u, int wr, int wc, int fr, int fq) const {
        const int row0 = u.pm * BM + wr * 64 + fr, col0 = u.pn * BM + wc * 32 + 8 * fq;
#pragma unroll
        for (int ai = 0; ai < 2; ++ai)
#pragma unroll
            for (int m = 0; m < 4; ++m) { const int R = row0 + ai * HALF + m * 16; const bool valid = true;
                float* yrow = out + OFF_YP + (size_t)R * DM + col0;
                const float* brow = FIRST ? (xp + (size_t)R * DM + col0) : yrow;
                float ss = 0.f;
#pragma unroll
                for (int bj = 0; bj < 2; ++bj) { f32x4 v0 = acc[ai][bj][m][0], v1 = acc[ai][bj][m][1];
                    if (valid) { v0 = v0 + *(const f32x4*)(brow + bj * HALF); v1 = v1 + *(const f32x4*)(brow + bj * HALF + 4);
                        *(f32x4*)(yrow + bj * HALF) = v0; *(f32x4*)(yrow + bj * HALF + 4) = v1; }
                    ss += (v0[0] * v0[0] + v0[1] * v0[1]) + (v0[2] * v0[2] + v0[3] * v0[3]) + (v1[0] * v1[0] + v1[1] * v1[1]) + (v1[2] * v1[2] + v1[3] * v1[3]);
                    if (FIRST) *(u32x4*)(yb + (size_t)R * DM + col0 + bj * HALF) = pack8(v0, v1); }
                ss += __shfl_xor(ss, 16); ss += __shfl_xor(ss, 32);
                if (fq == 0 && valid) atomicAdd(rss + R, ss);
                asm volatile("" ::: "memory"); }
    }
};

struct EpiL1In {
    static constexpr bool PERM = true, AFTER_DRAIN = false;
    const float* rss; bf16_t* U; bf16_t* SG; float* out;
    __device__ __forceinline__ void operator()(const f32x4 (&acc)[2][2][4][2], const Unit& u, int wr, int wc, int fr, int fq) const {
        const int row0 = u.pm * BM + wr * 64 + fr;
        if (u.pn < 8) {
            const int ch = u.pn * HALF + wc * 32 + 8 * fq;
#pragma unroll
            for (int ai = 0; ai < 2; ++ai)
#pragma unroll
                for (int m = 0; m < 4; ++m) { const int R = row0 + ai * HALF + m * 16; const float rs = 1.0f / sqrtf(rss[R] * (1.0f / DM) + RMS_EPS);
                    f32x4 u0, u1;
#pragma unroll
                    for (int j = 0; j < 4; ++j) { u0[j] = (acc[ai][0][m][0][j] * rs) * sigmoid_f(acc[ai][1][m][0][j] * rs); u1[j] = (acc[ai][0][m][1][j] * rs) * sigmoid_f(acc[ai][1][m][1][j] * rs); }
                    *(u32x4*)(U + (size_t)R * DM + ch) = pack8(u0, u1);
                    { const int t = R & (SEQ - 1); if (t >= SEQ - 30) { float* d = out + OFF_C1P + ((size_t)(R >> 11) * 30 + (t - (SEQ - 30))) * DM + ch; *(f32x4*)d = u0; *(f32x4*)(d + 4) = u1; } } }
        } else {
            const int ch = (u.pn - 8) * BM + wc * 32 + 8 * fq;
#pragma unroll
            for (int ai = 0; ai < 2; ++ai)
#pragma unroll
                for (int m = 0; m < 4; ++m) { const int R = row0 + ai * HALF + m * 16; const float rs = 1.0f / sqrtf(rss[R] * (1.0f / DM) + RMS_EPS);
#pragma unroll
                    for (int bj = 0; bj < 2; ++bj) { f32x4 v0 = acc[ai][bj][m][0] * rs, v1 = acc[ai][bj][m][1] * rs;
#pragma unroll
                        for (int j = 0; j < 4; ++j) { v0[j] = silu_f(v0[j]); v1[j] = silu_f(v1[j]); }
                        *(u32x4*)(SG + (size_t)R * DM + ch + bj * HALF) = pack8(v0, v1); } }
        }
    }
};
template <class Epi, class Sched, bool ALIGN_EPI = false, bool SP2 = false>
__device__ __forceinline__ void gemm_phase(PG8_LAS unsigned char* lds, const Gemm g, const Sched& S, const Epi& E) {
    const int tid = threadIdx.x, wid = __builtin_amdgcn_readfirstlane(tid >> 6), lane = tid & 63, wr = wid >> 2, wc = wid & 3, fr = lane & 15, fq = lane >> 4;
    const int K = g.K, nt = K / BK;
    unsigned voffA[2], voffB[2];
#pragma unroll
    for (int i = 0; i < 2; ++i) { int R, C; stage_rc(tid * 16 + i * 8192, R, C); const int Rb = Epi::PERM ? ((R & ~31) + perm32(R & 31)) : R;
        voffA[i] = (unsigned)(R * K + C) * 2u; voffB[i] = (unsigned)(Rb * K + C) * 2u; }
    const size_t kstep = (size_t)(BK * 2);
    const size_t hstep = (size_t)HALF * K * 2;
    const size_t tstep = 2 * hstep;
    const unsigned ldsw = (unsigned)wid * 1024u;
    const int aoff = lds_byte(wr * 64 + fr, fq * 8), boff = lds_byte(wc * 32 + fr, fq * 8);
#define PG8_SA(b, h) (((b) * 2 + (h)) * HTB)
#define PG8_SB(b, h) ((4 + (b) * 2 + (h)) * HTB)
#define PG8_STAGE(bufoff, gbase, voff) do { _Pragma("unroll") for (int _i = 0; _i < 2; ++_i) \
        __builtin_amdgcn_global_load_lds((const unsigned*)((const char*)(gbase) + (voff)[_i]), (PG8_LAS unsigned*)(lds + (bufoff) + ldsw + _i * 8192), 16, 0, 0); } while (0)
#define PG8_LDA(dst, b, h) do { _Pragma("unroll") for (int m = 0; m < 4; ++m) _Pragma("unroll") for (int k = 0; k < 2; ++k) dst[m][k] = *(const PG8_LAS bf16x8*)(lds + PG8_SA(b, h) + aoff + m * 2048 + k * 1024); } while (0)
#define PG8_LDB(dst, b, h) do { _Pragma("unroll") for (int n = 0; n < 2; ++n) _Pragma("unroll") for (int k = 0; k < 2; ++k) dst[n][k] = *(const PG8_LAS bf16x8*)(lds + PG8_SB(b, h) + boff + n * 2048 + k * 1024); } while (0)
#define PG8_MMA(ai, bj, At, Bt) do { __builtin_amdgcn_s_setprio(1); _Pragma("unroll") for (int m = 0; m < 4; ++m) _Pragma("unroll") for (int n = 0; n < 2; ++n) _Pragma("unroll") for (int k = 0; k < 2; ++k) \
        acc[ai][bj][m][n] = __builtin_amdgcn_mfma_f32_16x16x32_bf16(Bt[n][k], At[m][k], acc[ai][bj][m][n], 0, 0, 0); __builtin_amdgcn_s_setprio(0); } while (0)
#define PG8_WAIT_V(n) asm volatile("s_waitcnt vmcnt(" #n ")" ::: "memory")
#define PG8_WAIT_L(n) asm volatile("s_waitcnt lgkmcnt(" #n ")" ::: "memory")
#define PG8_BAR __builtin_amdgcn_s_barrier()
#define PG8_SCHED __builtin_amdgcn_sched_barrier(0)
    Unit cur, nxt; int ui = 0;
    if (!S.next(0, cur)) return;
    f32x4 acc[2][2][4][2];
#pragma unroll
    for (int a = 0; a < 2; ++a)
#pragma unroll
        for (int b = 0; b < 2; ++b)
#pragma unroll
            for (int m = 0; m < 4; ++m)
#pragma unroll
                for (int n = 0; n < 2; ++n) acc[a][b][m][n] = (f32x4){0.f, 0.f, 0.f, 0.f};
    bf16x8 At[4][2], B0[2][2], B1[2][2];
    const char* cA = (const char*)g.A + (size_t)cur.pm * tstep; const char* cB = (const char*)g.Bt + (size_t)cur.pn * tstep;
    S.a_ready(cur);
    if constexpr (SP2) {
        PG8_STAGE(PG8_SB(0, 0), cB, voffB); PG8_STAGE(PG8_SB(0, 1), cB + hstep, voffB); PG8_STAGE(PG8_SA(0, 0), cA, voffA); PG8_STAGE(PG8_SA(0, 1), cA + hstep, voffA);
        if (wr == 1) PG8_BAR;
        PG8_WAIT_V(2); PG8_BAR;
        PG8_STAGE(PG8_SB(1, 0), cB + kstep, voffB); PG8_STAGE(PG8_SA(1, 0), cA + kstep, voffA); PG8_STAGE(PG8_SB(1, 1), cB + hstep + kstep, voffB);
        PG8_WAIT_V(6); PG8_BAR;
    } else {
        PG8_STAGE(PG8_SB(0, 0), cB, voffB); PG8_STAGE(PG8_SA(0, 0), cA, voffA); PG8_STAGE(PG8_SB(0, 1), cB + hstep, voffB); PG8_STAGE(PG8_SA(0, 1), cA + hstep, voffA);
        if (wr == 1) PG8_BAR;
        PG8_WAIT_V(4); PG8_BAR;
        PG8_STAGE(PG8_SB(1, 0), cB + kstep, voffB); PG8_STAGE(PG8_SA(1, 0), cA + kstep, voffA); PG8_STAGE(PG8_SB(1, 1), cB + hstep + kstep, voffB);
        PG8_WAIT_V(6); PG8_BAR;
    }
    for (;;) {
        const bool has_next = S.next(ui + 1, nxt);
        const char* nA = has_next ? (const char*)g.A + (size_t)nxt.pm * tstep : cA; const char* nB = has_next ? (const char*)g.Bt + (size_t)nxt.pn * tstep : cB;
        for (int t = 0; t < nt; t += 2) {
            const bool last = (t == nt - 2);
            const char* a1 = cA + (size_t)(t + 1) * kstep;
            const char* a2 = last ? nA : cA + (size_t)(t + 2) * kstep; const char* b2 = last ? nB : cB + (size_t)(t + 2) * kstep;
            const char* a3 = a2 + kstep; const char* b3 = b2 + kstep;
            if (last && has_next) S.a_ready(nxt);
            if constexpr (SP2) {
            PG8_LDB(B0, 0, 0); PG8_LDB(B1, 0, 1); PG8_SCHED; PG8_LDA(At, 0, 0); PG8_STAGE(PG8_SA(1, 1), a1 + hstep, voffA);
            PG8_WAIT_V(8); PG8_WAIT_L(0); PG8_BAR; PG8_MMA(0, 0, At, B0); PG8_MMA(0, 1, At, B1); PG8_BAR; PG8_SCHED;
            PG8_LDA(At, 0, 1); PG8_STAGE(PG8_SB(0, 0), b2, voffB); PG8_STAGE(PG8_SB(0, 1), b2 + hstep, voffB); PG8_STAGE(PG8_SA(0, 0), a2, voffA);
            PG8_WAIT_V(8); PG8_WAIT_L(0); PG8_BAR; PG8_MMA(1, 0, At, B0); PG8_MMA(1, 1, At, B1); PG8_BAR; PG8_SCHED;
            PG8_LDB(B0, 1, 0); PG8_LDB(B1, 1, 1); PG8_SCHED; PG8_LDA(At, 1, 0); PG8_STAGE(PG8_SA(0, 1), a2 + hstep, voffA);
            PG8_WAIT_V(8); PG8_WAIT_L(0); PG8_BAR; PG8_MMA(0, 0, At, B0); PG8_MMA(0, 1, At, B1); PG8_BAR; PG8_SCHED;
            PG8_LDA(At, 1, 1); PG8_STAGE(PG8_SB(1, 0), b3, voffB); PG8_STAGE(PG8_SB(1, 1), b3 + hstep, voffB); PG8_STAGE(PG8_SA(1, 0), a3, voffA);
            PG8_WAIT_V(8); PG8_WAIT_L(0); PG8_BAR; PG8_MMA(1, 0, At, B0); PG8_MMA(1, 1, At, B1); PG8_BAR; PG8_SCHED;
            } else {
            PG8_LDB(B0, 0, 0); PG8_SCHED; PG8_LDA(At, 0, 0); PG8_STAGE(PG8_SA(1, 1), a1 + hstep, voffA);
            PG8_WAIT_L(8); PG8_BAR; PG8_WAIT_L(0); PG8_MMA(0, 0, At, B0); PG8_BAR; PG8_SCHED;
            PG8_LDB(B1, 0, 1); PG8_STAGE(PG8_SB(0, 0), b2, voffB);
            PG8_BAR; PG8_WAIT_L(0); PG8_MMA(0, 1, At, B1); PG8_BAR;
            PG8_LDA(At, 0, 1); PG8_STAGE(PG8_SA(0, 0), a2, voffA);
            PG8_BAR; PG8_WAIT_L(0); PG8_MMA(1, 0, At, B0); PG8_BAR; PG8_SCHED;
            PG8_STAGE(PG8_SB(0, 1), b2 + hstep, voffB);
            PG8_WAIT_V(6); PG8_BAR; PG8_MMA(1, 1, At, B1); PG8_BAR;
            PG8_LDB(B0, 1, 0); PG8_SCHED; PG8_LDA(At, 1, 0); PG8_STAGE(PG8_SA(0, 1), a2 + hstep, voffA);
            PG8_WAIT_L(8); PG8_BAR; PG8_WAIT_L(0); PG8_MMA(0, 0, At, B0); PG8_BAR; PG8_SCHED;
            PG8_LDB(B1, 1, 1); PG8_STAGE(PG8_SB(1, 0), b3, voffB);
            PG8_BAR; PG8_WAIT_L(0); PG8_MMA(0, 1, At, B1); PG8_BAR;
            PG8_LDA(At, 1, 1); PG8_STAGE(PG8_SA(1, 0), a3, voffA);
            PG8_BAR; PG8_WAIT_L(0); PG8_MMA(1, 0, At, B0); PG8_BAR; PG8_SCHED;
            PG8_STAGE(PG8_SB(1, 1), b3 + hstep, voffB);
            PG8_WAIT_V(6); PG8_BAR; PG8_MMA(1, 1, At, B1); PG8_BAR;
            }
        }
        if constexpr (ALIGN_EPI) { if (wr == 0) PG8_BAR; }
        if constexpr (!Epi::AFTER_DRAIN) { E(acc, cur, wr, wc, fr, fq); S.done(cur); }
        if (!has_next) break;
#pragma unroll
        for (int a = 0; a < 2; ++a)
#pragma unroll
            for (int b = 0; b < 2; ++b)
#pragma unroll
                for (int m = 0; m < 4; ++m)
#pragma unroll
                    for (int n = 0; n < 2; ++n) acc[a][b][m][n] = (f32x4){0.f, 0.f, 0.f, 0.f};
        cur = nxt; cA = nA; cB = nB; ++ui;
        if constexpr (ALIGN_EPI) { if (wr == 1) PG8_BAR; }
    }
    PG8_WAIT_V(0);
    if constexpr (!ALIGN_EPI) { if (wr == 0) PG8_BAR; }
    PG8_BAR;
    if constexpr (Epi::AFTER_DRAIN) { E.fused(acc, cur, wr, wc, fr, fq, lds, wid, lane); S.done(cur); }
#undef PG8_SA
#undef PG8_SB
#undef PG8_STAGE
#undef PG8_LDA
#undef PG8_LDB
#undef PG8_MMA
#undef PG8_WAIT_V
#undef PG8_WAIT_L
#undef PG8_BAR
#undef PG8_SCHED
}
}

#ifndef PG8_SP2
#define PG8_SP2 true
#endif
#ifndef PG8_ALIGN
#define PG8_ALIGN true
#endif
#define GAS __attribute__((address_space(1)))
#define LAS __attribute__((address_space(3)))
typedef unsigned short bf16;
typedef unsigned v4u __attribute__((ext_vector_type(4)));
typedef float f32x4 __attribute__((ext_vector_type(4)));
typedef short bf16x8 __attribute__((ext_vector_type(8)));
typedef GAS unsigned gu32;
typedef GAS unsigned long long gu64;
#define RLX_AGENT __ATOMIC_RELAXED, __HIP_MEMORY_SCOPE_AGENT
#define LDS_WAIT() asm volatile("s_waitcnt lgkmcnt(0)" ::: "memory")
#define VM_WAIT() asm volatile("s_waitcnt vmcnt(0)" ::: "memory")
__device__ __forceinline__ unsigned long long rt() { return __builtin_amdgcn_s_memrealtime(); }
__device__ __forceinline__ unsigned f2bf(float f) { unsigned u = __builtin_bit_cast(unsigned, f); return (u + 0x7fffu + ((u >> 16) & 1u)) >> 16; }
__device__ __forceinline__ unsigned pk2(float lo, float hi) { return f2bf(lo) | (f2bf(hi) << 16); }
#define XB_TMO      128
#define XB_XCNT(j)  (256  + 64 * (j))
#define XB_XSUB(j)  (1280 + 64 * (j))
#define XB_XGEN(j)  (2304 + 64 * (j))
#define XB_TOP      3328
#define XB_TOPGEN   3392
#define XCD_BAR_WORDS 3456
#define XB_SPIN_CAP (1u << 18)

__device__ __forceinline__ unsigned xb_ld(unsigned* p)              { return __hip_atomic_load(p, __ATOMIC_RELAXED, __HIP_MEMORY_SCOPE_AGENT); }
__device__ __forceinline__ unsigned xb_add(unsigned* p, unsigned v) { return __hip_atomic_fetch_add(p, v, __ATOMIC_RELAXED, __HIP_MEMORY_SCOPE_AGENT); }
__device__ __forceinline__ unsigned xb_xcc_id() { return (unsigned)__builtin_amdgcn_s_getreg((3 << 11) | 20) & 0xFu; }
#define XB_SPIN(cond, bar) do { unsigned _sp = 0; while (cond) { __builtin_amdgcn_s_sleep(1); \
    if ((++_sp & 255u) == 0u) { if (xb_ld(&(bar)[XB_TMO])) break; if (_sp > XB_SPIN_CAP) { atomicAdd(&(bar)[XB_TMO], 1u); break; } } } } while (0)

struct XcdBarrier {
    unsigned* bar; unsigned x;
    volatile LAS unsigned* st;
};

__device__ __forceinline__ XcdBarrier xcd_barrier_post(unsigned* bar, volatile LAS unsigned* st) {
    XcdBarrier b; b.bar = bar; b.x = xb_xcc_id(); b.st = st;
    if (threadIdx.x == 0) (void)xb_add(&bar[XB_XCNT(b.x)], 1u);
    return b;
}
__device__ __forceinline__ void xcd_barrier_complete(unsigned* bar, unsigned x, unsigned& nloc, unsigned& nx) {
    const unsigned G = gridDim.x * gridDim.y * gridDim.z;
    unsigned sum, cnt, mine, sp = 0u;
    for (;;) {
        sum = 0u; cnt = 0u; mine = 0u;
#pragma unroll
        for (unsigned j = 0; j < 16; ++j) { const unsigned c = xb_ld(&bar[XB_XCNT(j)]); sum += c; cnt += (c > 0u) ? 1u : 0u; mine = (j == x) ? c : mine; }
        if (sum == G) break;
        __builtin_amdgcn_s_sleep(1);
        if ((++sp & 255u) == 0u) { if (xb_ld(&bar[XB_TMO])) break; if (sp > XB_SPIN_CAP) { atomicAdd(&bar[XB_TMO], 1u); break; } }
    }
    nloc = mine > 0u ? mine : 1u; nx = cnt > 0u ? cnt : 1u;
}

__device__ __forceinline__ void xcd_barrier(const XcdBarrier& b) {
    asm volatile("s_waitcnt vmcnt(0)" ::: "memory");
    __syncthreads();
    if (threadIdx.x == 0) {
        unsigned* bar = b.bar;
        __builtin_amdgcn_s_waitcnt(0);
        unsigned nloc = b.st[0], nx = b.st[1];
        if (nloc == 0u) { xcd_barrier_complete(bar, b.x, nloc, nx); b.st[0] = nloc; b.st[1] = nx; }
        const unsigned old = xb_add(&bar[XB_XSUB(b.x)], 1u);
        const unsigned gen = old / nloc;
        if (old + 1u == (gen + 1u) * nloc) {
            __builtin_amdgcn_fence(__ATOMIC_RELEASE, "agent");
            asm volatile("s_waitcnt vmcnt(0)" ::: "memory");
            const unsigned og = xb_add(&bar[XB_TOP], 1u);
            const unsigned tg = og / nx;
            if (og + 1u == (tg + 1u) * nx) xb_add(&bar[XB_TOPGEN], 1u);
            else XB_SPIN(xb_ld(&bar[XB_TOPGEN]) == tg, bar);
            __builtin_amdgcn_fence(__ATOMIC_ACQUIRE, "agent");
            xb_add(&bar[XB_XGEN(b.x)], 1u);
            asm volatile("s_waitcnt vmcnt(0)" ::: "memory");
        } else {
            XB_SPIN(xb_ld(&bar[XB_XGEN(b.x)]) == gen, bar);
            __builtin_amdgcn_fence(__ATOMIC_ACQUIRE, "agent");
            asm volatile("s_waitcnt vmcnt(0)" ::: "memory");
        }
    }
    __syncthreads();
}
constexpr int NWAVES = 8;
#ifndef PROBE_DUP
#define PROBE_DUP 0
#endif
#ifndef MK_N_LAUNCHES
#define MK_N_LAUNCHES 1
#endif
constexpr int N_PHASES = 8;
constexpr int N_LAUNCHES = MK_N_LAUNCHES;

constexpr size_t MiB = 1u << 20;
constexpr size_t WS_CTL = 0, CTL_ZERO_BYTES = 1 * MiB;
constexpr size_t WS_W0T = 2 * MiB;
constexpr size_t WS_WO0T = 9 * MiB;
constexpr size_t WS_W1T = 11 * MiB;
constexpr size_t WS_WO1T = 17 * MiB;
constexpr size_t WS_WSB = 19 * MiB;
constexpr size_t WS_KC = 20 * MiB, WS_VC = 36 * MiB;
constexpr size_t WS_XN = 52 * MiB;
constexpr size_t WS_ACT = 117 * MiB;
constexpr size_t WS_U = 117 * MiB, WS_SG = 182 * MiB;
constexpr size_t WS_A2 = 343 * MiB;
constexpr size_t WS_END = 408 * MiB;
static_assert(WS_XN + (size_t)MPAD * DM * 2 <= WS_ACT && WS_ACT + (size_t)MPAD * L0N * 2 <= WS_A2 && WS_A2 + (size_t)MPAD * DM * 2 <= WS_END, "d_ws map");
static_assert(WS_U + (size_t)MPAD * DM * 2 <= WS_SG && WS_SG + (size_t)MPAD * DM * 2 <= WS_A2, "d_ws overlay map");
constexpr int CW_BAR = 4096;
constexpr int CW_RS1 = 65536, CW_RS2 = 131072;
static_assert((CW_RS2 + MPAD) * 4 <= (int)CTL_ZERO_BYTES, "CTL words inside the memset region");

constexpr int RING_OFF = 0, RING_BYTES = 131072;
constexpr int LDSCTL_OFF = RING_BYTES, MISC_OFF = LDSCTL_OFF + 320;
constexpr int AUX_OFF = RING_BYTES + 1024;
constexpr int LDS_BYTES = 147456;
static_assert(AUX_OFF + 8192 <= LDS_BYTES, "LDS map");
typedef float f32x2 __attribute__((ext_vector_type(2)));
typedef unsigned u32x2 __attribute__((ext_vector_type(2)));
struct Frame {
    LAS unsigned char* lds;
    volatile LAS unsigned* MISC;
    gu32* ctl;
    int tid, lane, wave;
    int vcu, G;
    const float *xp, *xs, *ck, *cv, *cstate, *relb, *g0, *win0, *lq1, *lk1, *lq2, *lk2, *subg, *gvg, *gvb, *wsp, *bsp, *wout0, *g1, *win1, *wdw, *bdw, *clg, *clb, *wout1, *gf;
    float* out;
    bf16 *W0t, *Wo0t, *W1t, *Wo1t, *WSb, *KC, *VC, *XN, *ACT, *U, *SG, *A2;
    float *RS1, *RS2;
};

__device__ __forceinline__ float wave_sum(float v) {
#pragma unroll
    for (int o = 1; o < 64; o <<= 1) v += __shfl_xor(v, o);
    return v;
}
__device__ __forceinline__ void p0_transpose_item(const float* W, int K, int N, bf16* WT, int k0, int n0, int dst_n0, const float* kscale, LAS float* scr, int lane) {
#pragma unroll 8
    for (int i = 0; i < 32; ++i) { const int kk = 2 * i + (lane >> 5); float w = W[(size_t)(k0 + kk) * N + n0 + (lane & 31)]; if (kscale) w *= kscale[k0 + kk]; scr[kk * 33 + (lane & 31)] = w; }
    LDS_WAIT(); asm volatile("" ::: "memory");
    const int c = lane & 7;
#pragma unroll
    for (int j = 0; j < 4; ++j) { const int n = (lane >> 3) + 8 * j; const LAS float* s = scr + (8 * c) * 33 + n;
        v4u o; o.x = pk2(s[0 * 33], s[1 * 33]); o.y = pk2(s[2 * 33], s[3 * 33]); o.z = pk2(s[4 * 33], s[5 * 33]); o.w = pk2(s[6 * 33], s[7 * 33]);
        *(GAS v4u*)(WT + (size_t)(dst_n0 + n) * K + k0 + 8 * c) = o; }
    LDS_WAIT(); asm volatile("" ::: "memory");
}
__device__ __forceinline__ void rms_row_to_bf16(const float* xrow, const float* gain, bf16* orow, int lane) {
    const GAS f32x4* xr = (const GAS f32x4*)xrow + lane; const GAS f32x4* gr = (const GAS f32x4*)gain + lane;
    f32x4 v[4]; float s = 0.f;
#pragma unroll
    for (int j = 0; j < 4; ++j) { v[j] = xr[64 * j]; s += (v[j].x * v[j].x + v[j].y * v[j].y) + (v[j].z * v[j].z + v[j].w * v[j].w); }
    const float rs = 1.f / sqrtf(wave_sum(s) * (1.f / DM) + RMS_EPS);
    GAS unsigned long long* o8 = (GAS unsigned long long*)orow + lane;
#pragma unroll
    for (int j = 0; j < 4; ++j) { const f32x4 g = gr[64 * j]; const f32x4 y = v[j] * rs * g;
        o8[64 * j] = (unsigned long long)pk2(y.x, y.y) | ((unsigned long long)pk2(y.z, y.w) << 32); }
}
__device__ __forceinline__ void p0_prologue(Frame& F) {
    LAS float* scr = (LAS float*)(F.lds + RING_OFF + F.wave * 16384);
    const int gw = F.vcu * NWAVES + F.wave, NGW = F.G * NWAVES;
    constexpr int I_IN0 = 16 * (L0N / 32), I_O = 16 * 32, I_IN1 = 16 * (L1N / 32);
    constexpr int NITEMS = I_IN0 + I_O + I_IN1 + I_O;
    for (int it = gw; it < NITEMS; it += NGW) {
        int r = it;
        if (r < I_IN0) { const int nb = L0N / 32, k0 = 64 * (r / nb), n0 = 32 * (r % nb); p0_transpose_item(F.win0, DM, L0N, F.W0t, k0, n0, n0, nullptr, scr, F.lane); continue; } r -= I_IN0;
        if (r < I_O) { const int k0 = 64 * (r / 32), n0 = 32 * (r % 32); p0_transpose_item(F.wout0, DM, DM, F.Wo0t, k0, n0, n0, nullptr, scr, F.lane); continue; } r -= I_O;
        if (r < I_IN1) { const int nb = L1N / 32, k0 = 64 * (r / nb), n0 = 32 * (r % nb);
            int d0; if (n0 < 1024) d0 = 256 * (n0 >> 7) + (n0 & 127); else if (n0 < 2048) d0 = 256 * ((n0 - 1024) >> 7) + 128 + (n0 & 127); else d0 = n0;
            p0_transpose_item(F.win1, DM, L1N, F.W1t, k0, n0, d0, F.g1, scr, F.lane); continue; } r -= I_IN1;
        { const int k0 = 64 * (r / 32), n0 = 32 * (r % 32); p0_transpose_item(F.wout1, DM, DM, F.Wo1t, k0, n0, n0, nullptr, scr, F.lane); }
    }
    { int m0 = gw;
      for (; m0 + 3 * NGW < MP; m0 += 4 * NGW) {
        f32x4 v[4][4], g[4];
#pragma unroll
        for (int q = 0; q < 4; ++q) { const GAS f32x4* xr = (const GAS f32x4*)(F.xp + (size_t)(m0 + q * NGW) * DM) + F.lane;
#pragma unroll
            for (int j = 0; j < 4; ++j) v[q][j] = xr[64 * j]; }
#pragma unroll
        for (int j = 0; j < 4; ++j) g[j] = ((const GAS f32x4*)F.g0 + F.lane)[64 * j];
#pragma unroll
        for (int q = 0; q < 4; ++q) { float s = 0.f;
#pragma unroll
            for (int j = 0; j < 4; ++j) s += (v[q][j].x * v[q][j].x + v[q][j].y * v[q][j].y) + (v[q][j].z * v[q][j].z + v[q][j].w * v[q][j].w);
            const float rs = 1.f / sqrtf(wave_sum(s) * (1.f / DM) + RMS_EPS);
            GAS unsigned long long* o8 = (GAS unsigned long long*)(F.XN + (size_t)(m0 + q * NGW) * DM) + F.lane;
#pragma unroll
            for (int j = 0; j < 4; ++j) { const f32x4 y = v[q][j] * rs * g[j]; o8[64 * j] = (unsigned long long)pk2(y.x, y.y) | ((unsigned long long)pk2(y.z, y.w) << 32); } }
      }
      for (; m0 < MP; m0 += NGW) rms_row_to_bf16(F.xp + (size_t)m0 * DM, F.g0, F.XN + (size_t)m0 * DM, F.lane);
      for (int m = MP + gw; m < MPAD; m += NGW) {
        if (m < MV) rms_row_to_bf16(F.xs + (size_t)(m - MP) * DM, F.g0, F.XN + (size_t)m * DM, F.lane);
        else { GAS unsigned long long* o8 = (GAS unsigned long long*)(F.XN + (size_t)m * DM) + F.lane;
#pragma unroll
            for (int j = 0; j < 4; ++j) o8[64 * j] = 0ull; } }
    }
    { const long n8 = (long)SB * PAST * 512 / 8, gt = (long)F.vcu * (NWAVES * 64) + F.tid, NT = (long)F.G * NWAVES * 64;
      long i0 = gt;
      for (; i0 + 3 * NT < 2 * n8; i0 += 4 * NT) {
          f32x4 a[4], b[4];
#pragma unroll
          for (int q = 0; q < 4; ++q) { const long i = i0 + q * NT; const bool isk = i < n8; const long j = isk ? i : i - n8; const GAS f32x4* sp = (const GAS f32x4*)((isk ? F.ck : F.cv) + j * 8); a[q] = sp[0]; b[q] = sp[1]; }
#pragma unroll
          for (int q = 0; q < 4; ++q) { const long i = i0 + q * NT; const bool isk = i < n8; const long j = isk ? i : i - n8;
              v4u o; o.x = pk2(a[q].x, a[q].y); o.y = pk2(a[q].z, a[q].w); o.z = pk2(b[q].x, b[q].y); o.w = pk2(b[q].z, b[q].w);
              *(GAS v4u*)((isk ? F.KC : F.VC) + j * 8) = o; } }
      for (; i0 < 2 * n8; i0 += NT) { const bool isk = i0 < n8; const long j = isk ? i0 : i0 - n8; const GAS f32x4* sp = (const GAS f32x4*)((isk ? F.ck : F.cv) + j * 8); const f32x4 a = sp[0], b = sp[1];
          v4u o; o.x = pk2(a.x, a.y); o.y = pk2(a.z, a.w); o.z = pk2(b.x, b.y); o.w = pk2(b.z, b.w); *(GAS v4u*)((isk ? F.KC : F.VC) + j * 8) = o; }
      for (long i = gt; i < 4 * 128 * 128; i += NT) { const int ii = (int)(i >> 7) & 127, jj = (int)i & 127; F.WSb[i] = (bf16)f2bf(jj <= ii ? F.wsp[i] : 0.f); }
      for (long i = gt; i < (long)SB * 14 * DM; i += NT) { const int bs = (int)(i / (14 * DM)), rem = (int)(i % (14 * DM)); F.out[OFF_C1S + (size_t)bs * 30 * DM + rem] = F.cstate[(size_t)bs * 30 * DM + 16 * DM + rem]; }
    }
}
namespace att {
using bf16x8 = __attribute__((ext_vector_type(8))) short;
using s16x4  = __attribute__((ext_vector_type(4))) short;
using f32x16 = __attribute__((ext_vector_type(16))) float;
using u32x4  = __attribute__((ext_vector_type(4))) unsigned;
#define KSWZ(row, colB) ((row) * 256 + ((colB) ^ (((row) & 7) << 4)))
#define SBAR() __builtin_amdgcn_sched_barrier(0)
constexpr int LDS_V = 0, LDS_K = 32768, TILE_B = 16384, LDS_XCH = 0, XP = 132, LDS_SCR = 69632;
constexpr int BT_N = 320;
constexpr float THRL = 8.f;
__device__ __forceinline__ int crow(int r, int hi) { return (r & 3) + 8 * (r >> 2) + 4 * hi; }
__device__ __forceinline__ unsigned cvtpk(float lo, float hi) { unsigned r; asm volatile("v_cvt_pk_bf16_f32 %0, %1, %2" : "=v"(r) : "v"(lo), "v"(hi)); return r; }
__device__ __forceinline__ int v_st(int k, int c) { const int kk = (k & ~0xC) | ((k & 4) << 1) | ((k & 8) >> 1); return ((kk >> 3) * 4 + (c >> 5)) * 512 + ((kk & 7) * 32 + (c & 31)) * 2; }
__device__ __forceinline__ int v_rd_base(int lane) { return ((lane & 3) << 3) | (((lane >> 2) & 3) << 6) | (((lane >> 4) & 1) << 5) | (((lane >> 5) & 1) << 8); }
constexpr int v_rd_off(int d0, int ks, int half) { return d0 * 512 + ks * 4096 + half * 2048; }
template <int OFF> __device__ __forceinline__ s16x4 tr_read(int vb) { s16x4 r; asm volatile("ds_read_b64_tr_b16 %0, %1 offset:%2" : "=&v"(r) : "v"(vb), "i"(OFF) : "memory"); return r; }
template <int D0> __device__ __forceinline__ void pv_one(f32x16& od, int vb, bf16x8 pa0, bf16x8 pa1, bf16x8 pa2, bf16x8 pa3) {
    const s16x4 l0 = tr_read<v_rd_off(D0, 0, 0)>(vb), h0 = tr_read<v_rd_off(D0, 0, 1)>(vb), l1 = tr_read<v_rd_off(D0, 1, 0)>(vb), h1 = tr_read<v_rd_off(D0, 1, 1)>(vb);
    const s16x4 l2 = tr_read<v_rd_off(D0, 2, 0)>(vb), h2 = tr_read<v_rd_off(D0, 2, 1)>(vb), l3 = tr_read<v_rd_off(D0, 3, 0)>(vb), h3 = tr_read<v_rd_off(D0, 3, 1)>(vb);
    asm volatile("s_waitcnt lgkmcnt(0)" ::: "memory"); SBAR();
#define PK(L, H) (bf16x8){L[0], L[1], L[2], L[3], H[0], H[1], H[2], H[3]}
    od = __builtin_amdgcn_mfma_f32_32x32x16_bf16(pa0, PK(l0, h0), od, 0, 0, 0);
    od = __builtin_amdgcn_mfma_f32_32x32x16_bf16(pa1, PK(l1, h1), od, 0, 0, 0);
    od = __builtin_amdgcn_mfma_f32_32x32x16_bf16(pa2, PK(l2, h2), od, 0, 0, 0);
    od = __builtin_amdgcn_mfma_f32_32x32x16_bf16(pa3, PK(l3, h3), od, 0, 0, 0);
#undef PK
}
__device__ __forceinline__ float bf2f(unsigned short b) { return __uint_as_float((unsigned)b << 16); }

__device__ __forceinline__ void attn_setup(Frame& F) {
    LAS float* BT = (LAS float*)(F.lds + AUX_OFF);
    for (int i = F.tid; i < 4 * BT_N; i += NWAVES * 64) {
        const int h = i / BT_N, rel = (i % BT_N) - 256, n = rel < 0 ? -rel : rel;
        const int mag = n < 8 ? n : n < 12 ? 8 : n < 16 ? 9 : n < 23 ? 10 : n < 32 ? 11 : n < 46 ? 12 : n < 64 ? 13 : n < 91 ? 14 : 15;
        const int bucket = (rel > 0 ? 16 : 0) + mag;
        BT[i] = (F.relb[bucket * 4 + h] - F.relb[15 * 4 + h]) * LOG2E;
    }
    if (F.wave == 0) {
        const float a = wave_sum(F.lq1[F.lane] * F.lk1[F.lane]), b = wave_sum(F.lq2[F.lane] * F.lk2[F.lane]);
        if (F.lane == 0) *(LAS float*)(F.lds + AUX_OFF + 4 * BT_N * 4) = expf(a) - expf(b) + 0.2f;
    }
    __syncthreads();
}

template <bool SAMPLE>
__device__ __forceinline__ void attn_unit(Frame& F, int b, int h, int qt) {
    const int tid = F.tid, lane = F.lane, wid = F.wave, r32 = lane & 31, hi = lane >> 5;
    const int rg = wid & 3, c = wid >> 2;
    LAS unsigned char* ring = F.lds + RING_OFF;
    LAS float* scr = (LAS float*)(ring + LDS_SCR) + wid * 64;
    const LAS float* BT = (const LAS float*)(F.lds + AUX_OFF) + h * BT_N;
    const float lam = *(const LAS float*)(F.lds + AUX_OFF + 4 * BT_N * 4);
    const int qpos0 = SAMPLE ? PAST : 128 * qt;
    const size_t qrow0 = SAMPLE ? (size_t)MP + 16 * b : (size_t)b * SEQ + 128 * qt;
    const int NT = SAMPLE ? 33 : 2 * qt + 2;
    const int last_active = SAMPLE ? (rg == 0 ? 32 : -1) : 2 * qt + (rg >> 1);
    bf16x8 qr[4];
    { const bf16* Qw = F.ACT + (qrow0 + 32 * rg + r32) * L0N + h * 128 + 64 * c + hi * 8;
#pragma unroll
      for (int d0 = 0; d0 < 4; ++d0) qr[d0] = *(const GAS bf16x8*)(Qw + 16 * d0); }
    const int sr = tid >> 4, sc = (tid & 15) * 8, vst0 = v_st(sr, sc), vst1 = v_st(32 + sr, sc);
    const int vb0 = (int)(uintptr_t)(ring + LDS_V) + v_rd_base(lane);
    bf16x8 ks0, ks1, vs0, vs1;
#define SLOAD(j) do { const bf16 *kp_, *vp_; size_t pitch_; \
        if (SAMPLE && (j) < 32) { kp_ = F.KC + ((size_t)b * PAST + 64 * (j)) * 512 + h * 128 + sc; vp_ = F.VC + ((size_t)b * PAST + 64 * (j)) * 512 + h * 128 + sc; pitch_ = 512; } \
        else { const size_t r0_ = SAMPLE ? (size_t)MP + 16 * b : (size_t)b * SEQ + 64 * (j); kp_ = F.ACT + r0_ * L0N + 512 + h * 128 + sc; vp_ = kp_ + 512; pitch_ = L0N; } \
        ks0 = *(const GAS bf16x8*)(kp_ + (size_t)sr * pitch_); ks1 = *(const GAS bf16x8*)(kp_ + (size_t)(32 + sr) * pitch_); \
        vs0 = *(const GAS bf16x8*)(vp_ + (size_t)sr * pitch_); vs1 = *(const GAS bf16x8*)(vp_ + (size_t)(32 + sr) * pitch_); } while (0)
#define SWRITE(bf) do { *(LAS bf16x8*)(ring + LDS_V + (bf) * TILE_B + vst0) = vs0; *(LAS bf16x8*)(ring + LDS_V + (bf) * TILE_B + vst1) = vs1; \
        *(LAS bf16x8*)(ring + LDS_K + (bf) * TILE_B + KSWZ(sr, sc * 2)) = ks0; *(LAS bf16x8*)(ring + LDS_K + (bf) * TILE_B + KSWZ(32 + sr, sc * 2)) = ks1; } while (0)
    float m_reg = -1e30f, l_reg = 0.f; f32x16 o[4];
#pragma unroll
    for (int d = 0; d < 4; ++d) o[d] = f32x16{};
    SLOAD(0); VM_WAIT(); SWRITE(0); __syncthreads();
    for (int j = 0; j < NT; ++j) {
        const int buf = j & 1;
        if (j + 1 < NT) SLOAD(j + 1);
        if (j <= last_active) {
            f32x16 p0 = f32x16{}, p1 = f32x16{};
            const LAS unsigned char* Ks = ring + LDS_K + buf * TILE_B;
#pragma unroll
            for (int d0 = 0; d0 < 4; ++d0) { const int cb = (64 * c + d0 * 16 + hi * 8) * 2;
                const bf16x8 b0 = *(const LAS bf16x8*)(Ks + KSWZ(r32, cb)), b1 = *(const LAS bf16x8*)(Ks + KSWZ(32 + r32, cb));
                p0 = __builtin_amdgcn_mfma_f32_32x32x16_bf16(b0, qr[d0], p0, 0, 0, 0);
                p1 = __builtin_amdgcn_mfma_f32_32x32x16_bf16(b1, qr[d0], p1, 0, 0, 0); }
            if ((qpos0 + 32 * rg) - (64 * j + 63) < 91) {
                const LAS float* bt = BT + (64 * j - (qpos0 + 32 * rg + r32) + 256 + 4 * hi);
#pragma unroll
                for (int r = 0; r < 16; ++r) { const int kk = (r & 3) + 8 * (r >> 2); p0[r] += bt[kk]; p1[r] += bt[32 + kk]; }
            }
            if (SAMPLE && j == 32) {
#pragma unroll
                for (int r = 0; r < 16; ++r) { if (crow(r, hi) >= ST) p0[r] = -INFINITY; p1[r] = -INFINITY; }
            }
            float pmax = p0[0];
#pragma unroll
            for (int r = 1; r < 16; ++r) pmax = fmaxf(pmax, p0[r]);
#pragma unroll
            for (int r = 0; r < 16; ++r) pmax = fmaxf(pmax, p1[r]);
            { auto rr = __builtin_amdgcn_permlane32_swap(__float_as_uint(pmax), __float_as_uint(pmax), false, false); pmax = fmaxf(__uint_as_float(rr[0]), __uint_as_float(rr[1])); }
            float alpha = 1.f;
            if (!__all(pmax - m_reg <= THRL)) { const float mn = fmaxf(m_reg, pmax); alpha = __builtin_amdgcn_exp2f(m_reg - mn); m_reg = mn;
                if (hi == 0) scr[r32] = alpha; LDS_WAIT();
#pragma unroll
                for (int d = 0; d < 4; ++d)
#pragma unroll
                    for (int r = 0; r < 16; ++r) o[d][r] *= scr[crow(r, hi)];
            }
            float ps = 0.f;
#pragma unroll
            for (int r = 0; r < 16; ++r) { p0[r] = __builtin_amdgcn_exp2f(p0[r] - m_reg); p1[r] = __builtin_amdgcn_exp2f(p1[r] - m_reg); ps += p0[r] + p1[r]; }
            { auto rr = __builtin_amdgcn_permlane32_swap(__float_as_uint(ps), __float_as_uint(ps), false, false); ps = __uint_as_float(rr[0]) + __uint_as_float(rr[1]); }
            l_reg = l_reg * alpha + ps;
            bf16x8 pa0, pa1, pa2, pa3;
#define PK4(P, BASE, OUT) do { unsigned a0 = cvtpk(P[BASE + 0], P[BASE + 1]), a1 = cvtpk(P[BASE + 2], P[BASE + 3]);   \
    unsigned b0_ = cvtpk(P[BASE + 4], P[BASE + 5]), b1_ = cvtpk(P[BASE + 6], P[BASE + 7]);                              \
    auto r0 = __builtin_amdgcn_permlane32_swap(a0, b0_, false, false); auto r1 = __builtin_amdgcn_permlane32_swap(a1, b1_, false, false); \
    u32x4 w = {r0[0], r1[0], r0[1], r1[1]}; OUT = *reinterpret_cast<bf16x8*>(&w); } while (0)
            PK4(p0, 0, pa0); PK4(p0, 8, pa1); PK4(p1, 0, pa2); PK4(p1, 8, pa3);
#undef PK4
            const int vb = vb0 + buf * TILE_B;
            pv_one<0>(o[0], vb, pa0, pa1, pa2, pa3); pv_one<1>(o[1], vb, pa0, pa1, pa2, pa3); pv_one<2>(o[2], vb, pa0, pa1, pa2, pa3); pv_one<3>(o[3], vb, pa0, pa1, pa2, pa3);
        }
        if (j + 1 < NT) { VM_WAIT(); SWRITE((j + 1) & 1); }
        __syncthreads();
    }
#undef SLOAD
#undef SWRITE
    const bool active = last_active >= 0;
    LAS float* X = (LAS float*)(ring + LDS_XCH) + rg * (32 * XP);
    float rli[16];
    if (active) { if (hi == 0) scr[r32] = l_reg; LDS_WAIT();
#pragma unroll
        for (int r = 0; r < 16; ++r) rli[r] = __builtin_amdgcn_rcpf(scr[crow(r, hi)]); }
    if (active && c == 1) {
#pragma unroll
        for (int r = 0; r < 16; ++r)
#pragma unroll
            for (int d = 0; d < 4; ++d) X[crow(r, hi) * XP + 32 * d + r32] = lam * o[d][r] * rli[r];
    }
    __syncthreads();
    if (active && c == 0) {
#pragma unroll
        for (int r = 0; r < 16; ++r)
#pragma unroll
            for (int d = 0; d < 4; ++d) { const int ix = crow(r, hi) * XP + 32 * d + r32; X[ix] = o[d][r] * rli[r] - X[ix]; }
        LDS_WAIT();
#pragma unroll
        for (int it = 0; it < 4; ++it) {
            const int row = it * 8 + (lane >> 3), col = (lane & 7) * 16;
            f32x4 v[4]; float ss = 0.f;
#pragma unroll
            for (int k = 0; k < 4; ++k) { v[k] = *(const LAS f32x4*)(X + row * XP + col + 4 * k); ss += (v[k].x * v[k].x + v[k].y * v[k].y) + (v[k].z * v[k].z + v[k].w * v[k].w); }
            ss += __shfl_xor(ss, 1); ss += __shfl_xor(ss, 2); ss += __shfl_xor(ss, 4);
            const float rstd = (1.0f - 0.2f) / sqrtf(ss * (1.f / 128.f) + RMS_EPS);
            const size_t R = qrow0 + 32 * rg + row;
            if (!SAMPLE || row < ST) {
                const GAS bf16x8* gp = (const GAS bf16x8*)(F.ACT + R * L0N + 1536 + h * 128 + col); const bf16x8 g0 = gp[0], g1 = gp[1];
                const GAS f32x4* sg = (const GAS f32x4*)(F.subg + col);
                float y[16];
#pragma unroll
                for (int k = 0; k < 4; ++k) { const f32x4 s4 = sg[k];
#pragma unroll
                    for (int e = 0; e < 4; ++e) { const int ix = 4 * k + e; const float ga = bf2f((unsigned short)(ix < 8 ? g0[ix] : g1[ix - 8])); y[ix] = v[k][e] * rstd * s4[e] * ga; } }
                v4u w0, w1; w0.x = pk2(y[0], y[1]); w0.y = pk2(y[2], y[3]); w0.z = pk2(y[4], y[5]); w0.w = pk2(y[6], y[7]); w1.x = pk2(y[8], y[9]); w1.y = pk2(y[10], y[11]); w1.z = pk2(y[12], y[13]); w1.w = pk2(y[14], y[15]);
                GAS v4u* op = (GAS v4u*)(F.A2 + R * DM + h * 128 + col); op[0] = w0; op[1] = w1;
            }
        }
    }
    __syncthreads();
}
#undef KSWZ
#undef SBAR
}
namespace gate {
using bf16x8 = __attribute__((ext_vector_type(8))) short;
using f32x16 = __attribute__((ext_vector_type(16))) float;
constexpr int ZP = 136, LDS_ZT = 0, LDS_D = 36864, DP = 132;
__device__ __forceinline__ int crow(int r, int hi) { return (r & 3) + 8 * (r >> 2) + 4 * hi; }
__device__ __forceinline__ float bf2f(unsigned short b) { return __uint_as_float((unsigned)b << 16); }

__device__ __forceinline__ void gate_unit(Frame& F, size_t R0, int T, int g, float* gvs) {
    const int tid = F.tid, lane = F.lane, wid = F.wave;
    LAS unsigned char* ring = F.lds + RING_OFF;
    LAS unsigned short* ZT = (LAS unsigned short*)(ring + LDS_ZT);
    LAS float* Dm = (LAS float*)(ring + LDS_D);
    { const int j = tid >> 2, c0 = (tid & 3) * 32;
      float x[32];
      if (j < T) { const GAS bf16x8* p = (const GAS bf16x8*)(F.ACT + (R0 + j) * L0N + 2560 + g * 128 + c0);
#pragma unroll
          for (int k = 0; k < 4; ++k) { const bf16x8 v = p[k];
#pragma unroll
              for (int e = 0; e < 8; ++e) x[8 * k + e] = bf2f((unsigned short)v[e]); } }
      else {
#pragma unroll
          for (int e = 0; e < 32; ++e) x[e] = 0.f; }
      float s = 0.f;
#pragma unroll
      for (int e = 0; e < 32; ++e) s += x[e];
      s += __shfl_xor(s, 1); s += __shfl_xor(s, 2);
      const float mean = s * (1.f / 128.f); float q = 0.f;
#pragma unroll
      for (int e = 0; e < 32; ++e) { x[e] -= mean; q += x[e] * x[e]; }
      q += __shfl_xor(q, 1); q += __shfl_xor(q, 2);
      const float rstd = 1.f / sqrtf(q * (1.f / 128.f) + LN_EPS);
      const float* lg = F.gvg + g * 128 + c0; const float* lb = F.gvb + g * 128 + c0;
#pragma unroll
      for (int e = 0; e < 32; ++e) { float y = (j < T) ? x[e] * rstd * lg[e] + lb[e] : 0.f; x[e] = y; ZT[(c0 + e) * ZP + j] = (unsigned short)f2bf(y); }
      if (gvs && j < T) { GAS f32x4* d = (GAS f32x4*)(gvs + (size_t)j * 512 + g * 128 + c0);
#pragma unroll
          for (int k = 0; k < 8; ++k) d[k] = (f32x4){x[4 * k], x[4 * k + 1], x[4 * k + 2], x[4 * k + 3]}; }
    }
    __syncthreads();
    { const int ib = wid >> 1, ch = wid & 1, r32 = lane & 31, hi = lane >> 5;
      f32x16 acc0 = f32x16{}, acc1 = f32x16{};
      const bf16* wrow = F.WSb + ((size_t)g * 128 + 32 * ib + r32) * 128 + 8 * hi;
      const LAS unsigned short* z0 = ZT + (32 * (2 * ch) + r32) * ZP + 8 * hi; const LAS unsigned short* z1 = z0 + 32 * ZP;
      const int nks = 2 * (ib + 1);
      for (int ks = 0; ks < nks; ++ks) {
          const bf16x8 a = *(const GAS bf16x8*)(wrow + 16 * ks);
          const bf16x8 b0 = *(const LAS bf16x8*)(z0 + 16 * ks), b1 = *(const LAS bf16x8*)(z1 + 16 * ks);
          acc0 = __builtin_amdgcn_mfma_f32_32x32x16_bf16(a, b0, acc0, 0, 0, 0);
          acc1 = __builtin_amdgcn_mfma_f32_32x32x16_bf16(a, b1, acc1, 0, 0, 0);
      }
#pragma unroll
      for (int r = 0; r < 16; ++r) { const int i = 32 * ib + crow(r, hi); Dm[i * DP + 32 * (2 * ch) + r32] = acc0[r]; Dm[i * DP + 32 * (2 * ch + 1) + r32] = acc1[r]; }
    }
    __syncthreads();
#pragma unroll
    for (int it = 0; it < 4; ++it) { const int p = tid + 512 * it, i = p >> 4, c8 = (p & 15) * 8;
        if (i < T) {
            const f32x4 d0 = *(const LAS f32x4*)(Dm + i * DP + c8), d1 = *(const LAS f32x4*)(Dm + i * DP + c8 + 4);
            const bf16* arow = F.ACT + (R0 + i) * L0N + g * 128 + c8;
            const bf16x8 zu = *(const GAS bf16x8*)(arow + 2048), sg = *(const GAS bf16x8*)(arow + 3072);
            const float bs = F.bsp[g * 128 + i];
            float y[8];
#pragma unroll
            for (int e = 0; e < 8; ++e) y[e] = bf2f((unsigned short)zu[e]) * ((e < 4 ? d0[e] : d1[e - 4]) + bs) * bf2f((unsigned short)sg[e]);
            v4u w; w.x = pk2(y[0], y[1]); w.y = pk2(y[2], y[3]); w.z = pk2(y[4], y[5]); w.w = pk2(y[6], y[7]);
            *(GAS v4u*)(F.A2 + (R0 + i) * DM + 512 + g * 128 + c8) = w;
        } }
}
}
namespace cv {
__device__ __forceinline__ float bf2f(unsigned short b) { return __uint_as_float((unsigned)b << 16); }
__device__ __forceinline__ void conv_segment(Frame& F, size_t R0, int t0, int L, const float* hist) {
    const int tid = F.tid, lane = F.lane, wid = F.wave, ch = 2 * tid;
    LAS float* tile = (LAS float*)(F.lds + RING_OFF);
    f32x2 w[CW];
#pragma unroll
    for (int j = 0; j < CW; ++j) w[j] = *(const GAS f32x2*)(F.wdw + (size_t)j * DM + ch);
    const f32x2 bd = *(const GAS f32x2*)(F.bdw + ch);
    f32x2 win[38];
#pragma unroll
    for (int i = 0; i < 30; ++i) { const int t = t0 - 30 + i;
        if (t >= 0) { const unsigned v = *(const GAS unsigned*)(F.U + (R0 + t) * DM + ch); win[i] = (f32x2){bf2f((unsigned short)(v & 0xffffu)), bf2f((unsigned short)(v >> 16))}; }
        else if (hist) win[i] = *(const GAS f32x2*)(hist + (size_t)(30 + t) * DM + ch);
        else win[i] = (f32x2){0.f, 0.f}; }
    unsigned nx[8];
#pragma unroll
    for (int o = 0; o < 8; ++o) nx[o] = *(const GAS unsigned*)(F.U + (R0 + t0 + o) * DM + ch);
    for (int tb = 0; tb < L; tb += 8) {
#pragma unroll
        for (int o = 0; o < 8; ++o) win[30 + o] = (f32x2){bf2f((unsigned short)(nx[o] & 0xffffu)), bf2f((unsigned short)(nx[o] >> 16))};
        if (tb + 8 < L) {
#pragma unroll
            for (int o = 0; o < 8; ++o) nx[o] = *(const GAS unsigned*)(F.U + (R0 + t0 + tb + 8 + o) * DM + ch); }
#pragma unroll
        for (int o = 0; o < 8; ++o) { f32x2 a = bd;
#pragma unroll
            for (int j = 0; j < CW; ++j) a = w[j] * win[o + j] + a;
            *(LAS f32x2*)(tile + ((tb & 31) + o) * DM + ch) = a; }
#pragma unroll
        for (int i = 0; i < 30; ++i) win[i] = win[i + 8];
        if (((tb + 8) & 31) == 0 || tb + 8 >= L) {
            const int tbase = tb & ~31, cnt = tb + 8 - tbase;
            __syncthreads();
#pragma unroll
            for (int q = 0; q < 4; ++q) { const int tk = wid + 8 * q; if (tk < cnt) {
                const LAS f32x4* row = (const LAS f32x4*)(tile + tk * DM) + lane;
                f32x4 v[4]; float s = 0.f;
#pragma unroll
                for (int k = 0; k < 4; ++k) { v[k] = row[64 * k]; s += (v[k].x + v[k].y) + (v[k].z + v[k].w); }
                const float mean = wave_sum(s) * (1.f / DM); float q2 = 0.f;
#pragma unroll
                for (int k = 0; k < 4; ++k) { v[k] = v[k] - mean; q2 += (v[k].x * v[k].x + v[k].y * v[k].y) + (v[k].z * v[k].z + v[k].w * v[k].w); }
                const float rstd = 1.f / sqrtf(wave_sum(q2) * (1.f / DM) + LN_EPS);
                const size_t R = R0 + t0 + tbase + tk;
#pragma unroll
                for (int k = 0; k < 4; ++k) { const int c4 = 4 * (lane + 64 * k);
                    const f32x4 lg = *(const GAS f32x4*)(F.clg + c4), lb = *(const GAS f32x4*)(F.clb + c4);
                    const u32x2 sg = *(const GAS u32x2*)(F.SG + R * DM + c4);
                    f32x4 y = v[k] * rstd * lg + lb;
                    const float g0 = bf2f((unsigned short)(sg.x & 0xffffu)), g1 = bf2f((unsigned short)(sg.x >> 16)), g2 = bf2f((unsigned short)(sg.y & 0xffffu)), g3 = bf2f((unsigned short)(sg.y >> 16));
                    y.x = pg8::silu_f(y.x) * g0; y.y = pg8::silu_f(y.y) * g1; y.z = pg8::silu_f(y.z) * g2; y.w = pg8::silu_f(y.w) * g3;
                    u32x2 o; o.x = pk2(y.x, y.y); o.y = pk2(y.z, y.w);
                    *(GAS u32x2*)(F.A2 + R * DM + c4) = o; }
            } }
            __syncthreads();
        }
    }
}
}
namespace sk {
using bf16x8 = __attribute__((ext_vector_type(8))) short;
using f32x16 = __attribute__((ext_vector_type(16))) float;
constexpr int PP = 68;
__device__ __forceinline__ int crow(int r, int hi) { return (r & 3) + 8 * (r >> 2) + 4 * hi; }
template <bool GLU, class Epi>
__device__ __forceinline__ void sample_gemm(Frame& F, const bf16* A, const bf16* Bt, int nunits, const Epi& E) {
    const int tid = F.tid, lane = F.lane, wid = F.wave, r32 = lane & 31, hi = lane >> 5;
    LAS float* P = (LAS float*)(F.lds + RING_OFF);
    for (int u = F.vcu; u < nunits; u += F.G) {
        const int rb = u & 3, q = u >> 2;
        const int brow0 = GLU ? 256 * (q >> 1) + 64 * (q & 1) + 128 * (wid >> 2) : 64 * q;
        constexpr int KW = GLU ? 256 : 128;
        const int k0 = (GLU ? (wid & 3) : wid) * KW;
        const bf16* ap = A + (size_t)(32 * rb + r32) * DM + k0 + 8 * hi;
        const bf16* bp = Bt + (size_t)(brow0 + r32) * DM + k0 + 8 * hi;
        f32x16 acc0 = f32x16{}, acc1 = f32x16{};
#pragma unroll 4
        for (int ks = 0; ks < KW / 16; ++ks) {
            const bf16x8 a = *(const GAS bf16x8*)(ap + 16 * ks), b0 = *(const GAS bf16x8*)(bp + 16 * ks), b1 = *(const GAS bf16x8*)(bp + (size_t)32 * DM + 16 * ks);
            acc0 = __builtin_amdgcn_mfma_f32_32x32x16_bf16(b0, a, acc0, 0, 0, 0);
            acc1 = __builtin_amdgcn_mfma_f32_32x32x16_bf16(b1, a, acc1, 0, 0, 0);
        }
        LAS float* pw = P + (wid * 32 + r32) * PP;
#pragma unroll
        for (int g = 0; g < 4; ++g) {
            *(LAS f32x4*)(pw + 8 * g + 4 * hi) = (f32x4){acc0[4 * g], acc0[4 * g + 1], acc0[4 * g + 2], acc0[4 * g + 3]};
            *(LAS f32x4*)(pw + 32 + 8 * g + 4 * hi) = (f32x4){acc1[4 * g], acc1[4 * g + 1], acc1[4 * g + 2], acc1[4 * g + 3]}; }
        __syncthreads();
        { const int m = tid >> 4, c4 = (tid & 15) * 4; const int R = MP + 32 * rb + m;
          if (GLU) { f32x4 a = (f32x4){0.f, 0.f, 0.f, 0.f}, b = a;
#pragma unroll
              for (int w = 0; w < 4; ++w) { a = a + *(const LAS f32x4*)(P + (w * 32 + m) * PP + c4); b = b + *(const LAS f32x4*)(P + ((w + 4) * 32 + m) * PP + c4); }
              E(R, 64 * q + c4, a, b);
          } else { f32x4 v = (f32x4){0.f, 0.f, 0.f, 0.f};
#pragma unroll
              for (int w = 0; w < 8; ++w) v = v + *(const LAS f32x4*)(P + (w * 32 + m) * PP + c4);
              E(R, 64 * q + c4, v, v); }
        }
        __syncthreads();
    }
}
__device__ __forceinline__ u32x2 pack4(const f32x4& v) { u32x2 w; w.x = pg8::cvt_pk_bf16(v[0], v[1]); w.y = pg8::cvt_pk_bf16(v[2], v[3]); return w; }
struct SkL0In { bf16* act; float* out;
    __device__ __forceinline__ void operator()(int R, int col, f32x4 v, const f32x4&) const {
        const int kind = col >> 9;
        if (kind == 0) v = v * C2;
        else if (kind == 1) *(GAS f32x4*)(out + OFF_K0S + (size_t)(R - MP) * 512 + (col - 512)) = v;
        else if (kind == 2) *(GAS f32x4*)(out + OFF_V0S + (size_t)(R - MP) * 512 + (col - 1024)) = v;
        else if (kind == 3 || kind == 6) { v[0] = pg8::silu_f(v[0]); v[1] = pg8::silu_f(v[1]); v[2] = pg8::silu_f(v[2]); v[3] = pg8::silu_f(v[3]); }
        else { v[0] = pg8::gelu_f(v[0]); v[1] = pg8::gelu_f(v[1]); v[2] = pg8::gelu_f(v[2]); v[3] = pg8::gelu_f(v[3]); }
        *(GAS u32x2*)(act + (size_t)R * L0N + col) = pack4(v); }
};
template <bool FIRST> struct SkRes { const float* xs; float* out; bf16* yb; float* rss;
    __device__ __forceinline__ void operator()(int R, int col, f32x4 v, const f32x4&) const {
        float* yrow = out + OFF_YS + (size_t)(R - MP) * DM + col; const float* brow = FIRST ? xs + (size_t)(R - MP) * DM + col : yrow;
        v = v + *(const GAS f32x4*)brow; *(GAS f32x4*)yrow = v;
        if (FIRST) *(GAS u32x2*)(yb + (size_t)R * DM + col) = pack4(v);
        float ss = (v[0] * v[0] + v[1] * v[1]) + (v[2] * v[2] + v[3] * v[3]);
        ss += __shfl_xor(ss, 1); ss += __shfl_xor(ss, 2); ss += __shfl_xor(ss, 4); ss += __shfl_xor(ss, 8);
        if ((threadIdx.x & 15) == 0) atomicAdd(rss + R, ss); }
};
struct SkL1Glu { const float* rss; bf16* U; float* out;
    __device__ __forceinline__ void operator()(int R, int ch, const f32x4& a, const f32x4& b) const {
        const float rs = 1.0f / sqrtf(rss[R] * (1.0f / DM) + RMS_EPS); f32x4 u;
#pragma unroll
        for (int j = 0; j < 4; ++j) u[j] = (a[j] * rs) * pg8::sigmoid_f(b[j] * rs);
        *(GAS u32x2*)(U + (size_t)R * DM + ch) = pack4(u);
        const int s = R - MP; *(GAS f32x4*)(out + OFF_C1S + ((size_t)(s >> 4) * 30 + 14 + (s & 15)) * DM + ch) = u; }
};
struct SkL1Gate { const float* rss; bf16* SG;
    __device__ __forceinline__ void operator()(int R, int col, f32x4 v, const f32x4&) const {
        const float rs = 1.0f / sqrtf(rss[R] * (1.0f / DM) + RMS_EPS);
#pragma unroll
        for (int j = 0; j < 4; ++j) v[j] = pg8::silu_f(v[j] * rs);
        *(GAS u32x2*)(SG + (size_t)R * DM + col) = pack4(v); }
};
}
struct Args { const float* in[26]; float* out; unsigned char* ws; int ph_lo, ph_hi; };
static_assert(sizeof(Args) == 28 * 8 + 8, "Args has no padding");
__global__ void __launch_bounds__(NWAVES * 64, 2) mega_fwd(Args args) {
    extern __shared__ __attribute__((aligned(16))) unsigned char lds[];
    Frame F;
    F.lds = (LAS unsigned char*)lds;
    F.MISC = (volatile LAS unsigned*)(F.lds + MISC_OFF);
    F.tid = threadIdx.x; F.lane = F.tid & 63; F.wave = __builtin_amdgcn_readfirstlane(F.tid >> 6);
    F.G = gridDim.x; { const int bx = blockIdx.x; F.vcu = (F.G % 8 == 0) ? (bx % 8) * (F.G / 8) + bx / 8 : bx; }
    unsigned char* ws = args.ws;
    F.ctl = (gu32*)(ws + WS_CTL);
    F.xp = args.in[0]; F.xs = args.in[1]; F.ck = args.in[2]; F.cv = args.in[3]; F.cstate = args.in[4]; F.relb = args.in[5]; F.g0 = args.in[6]; F.win0 = args.in[7];
    F.lq1 = args.in[8]; F.lk1 = args.in[9]; F.lq2 = args.in[10]; F.lk2 = args.in[11]; F.subg = args.in[12]; F.gvg = args.in[13]; F.gvb = args.in[14]; F.wsp = args.in[15]; F.bsp = args.in[16];
    F.wout0 = args.in[17]; F.g1 = args.in[18]; F.win1 = args.in[19]; F.wdw = args.in[20]; F.bdw = args.in[21]; F.clg = args.in[22]; F.clb = args.in[23]; F.wout1 = args.in[24]; F.gf = args.in[25];
    F.out = args.out;
    F.W0t = (bf16*)(ws + WS_W0T); F.Wo0t = (bf16*)(ws + WS_WO0T); F.W1t = (bf16*)(ws + WS_W1T); F.Wo1t = (bf16*)(ws + WS_WO1T); F.WSb = (bf16*)(ws + WS_WSB);
    F.KC = (bf16*)(ws + WS_KC); F.VC = (bf16*)(ws + WS_VC); F.XN = (bf16*)(ws + WS_XN); F.ACT = (bf16*)(ws + WS_ACT); F.U = (bf16*)(ws + WS_U); F.SG = (bf16*)(ws + WS_SG); F.A2 = (bf16*)(ws + WS_A2);
    F.RS1 = (float*)(ws + WS_CTL) + CW_RS1; F.RS2 = (float*)(ws + WS_CTL) + CW_RS2;
    for (int u = F.tid; u < (AUX_OFF - LDSCTL_OFF) / 4; u += NWAVES * 64) ((LAS unsigned*)(F.lds + LDSCTL_OFF))[u] = 0u;
    __syncthreads();
    XcdBarrier bar; bar.bar = (unsigned*)(F.ctl + CW_BAR); bar.x = 0; bar.st = nullptr;
    if (N_LAUNCHES == 1) bar = xcd_barrier_post((unsigned*)(F.ctl + CW_BAR), F.MISC + 8);
#define GRID_BAR() do { if (N_LAUNCHES == 1) xcd_barrier(bar); } while (0)
    const int lo = args.ph_lo, hi = args.ph_hi;
#define IN(k) (lo <= (k) && (k) < hi)
#define BOTH(k) (IN(k) && IN((k) + 1))

    if (IN(0)) { for (int rep = 0; rep <= ((PROBE_DUP >> 0) & 1); ++rep) p0_prologue(F); if (BOTH(0)) GRID_BAR(); }

    if (IN(1)) {
        { sk::SkL0In Es{F.ACT, F.out}; sk::sample_gemm<false>(F, F.XN + (size_t)MP * DM, F.W0t, 4 * (L0N / 64), Es); }
        pg8::Gemm g{F.XN, F.W0t, MP, L0N, DM}; pg8::StaticOrder S; S.init(MP, L0N, F.G, (int)blockIdx.x);
        pg8::EpiL0In E{F.ACT, F.out};
        for (int rep = 0; rep <= ((PROBE_DUP >> 1) & 1); ++rep) pg8::gemm_phase<pg8::EpiL0In, pg8::StaticOrder, PG8_ALIGN, PG8_SP2>(F.lds + RING_OFF, g, S, E);
        if (BOTH(1)) GRID_BAR();
    }

    if (IN(2)) {
        att::attn_setup(F);
        for (int rep = 0; rep <= ((PROBE_DUP >> 2) & 1); ++rep) {
        { const int bh = F.vcu >> 2, s = F.vcu & 3;
          if (F.G == 256) {
              for (int i = 0; i < 4; ++i) { const int qt = (i == 0) ? s : (i == 1) ? 7 - s : (i == 2) ? 8 + s : 15 - s; att::attn_unit<false>(F, bh >> 2, bh & 3, qt); }
          } else {
              for (int u = F.vcu; u < NB * 4 * 16; u += F.G) att::attn_unit<false>(F, u >> 6, (u >> 4) & 3, u & 15);
          }
          for (int u = F.vcu; u < SB * 4; u += F.G) att::attn_unit<true>(F, u >> 2, u & 3, 0);
        }
        }
        for (int rep = 0; rep <= ((PROBE_DUP >> 8) & 1); ++rep) {
        for (int u = F.vcu; u < NB * 16 * 4; u += F.G) { const int sq = u >> 6, n = (u >> 2) & 15, g = u & 3; gate::gate_unit(F, (size_t)sq * SEQ + 128 * n, 128, g, nullptr); }
        for (int u = F.vcu; u < SB * 4; u += F.G) { const int bs = u >> 2, g = u & 3; gate::gate_unit(F, (size_t)MP + ST * bs, ST, g, F.out + OFF_GVS + (size_t)bs * ST * 512); }
        }
        if (BOTH(2)) GRID_BAR();
    }

    if (IN(3)) {
        { sk::SkRes<true> Es{F.xs, F.out, F.XN, F.RS1}; sk::sample_gemm<false>(F, F.A2 + (size_t)MP * DM, F.Wo0t, 4 * (DM / 64), Es); }
        pg8::Gemm g{F.A2, F.Wo0t, MP, DM, DM}; pg8::StaticOrder S; S.init(MP, DM, F.G, (int)blockIdx.x);
        pg8::EpiRes<true> E{F.xp, F.xs, F.out, F.XN, F.RS1};
        pg8::gemm_phase<pg8::EpiRes<true>, pg8::StaticOrder, PG8_ALIGN, PG8_SP2>(F.lds + RING_OFF, g, S, E);
        if (BOTH(3)) GRID_BAR();
    }

    if (IN(4)) {
        { sk::SkL1Glu Ea{F.RS1, F.U, F.out}; sk::sample_gemm<true>(F, F.XN + (size_t)MP * DM, F.W1t, 4 * 16, Ea);
          sk::SkL1Gate Eg{F.RS1, F.SG}; sk::sample_gemm<false>(F, F.XN + (size_t)MP * DM, F.W1t + (size_t)2048 * DM, 4 * 16, Eg); }
        pg8::Gemm g{F.XN, F.W1t, MP, L1N, DM}; pg8::StaticOrder S; S.init(MP, L1N, F.G, (int)blockIdx.x);
        pg8::EpiL1In E{F.RS1, F.U, F.SG, F.out};
        for (int rep = 0; rep <= ((PROBE_DUP >> 4) & 1); ++rep) pg8::gemm_phase<pg8::EpiL1In, pg8::StaticOrder, PG8_ALIGN, PG8_SP2>(F.lds + RING_OFF, g, S, E);
        if (BOTH(4)) GRID_BAR();
    }

    if (IN(5)) {
        for (int rep = 0; rep <= ((PROBE_DUP >> 5) & 1); ++rep) {
        for (int sgm = F.vcu; sgm < NB * 16; sgm += F.G) cv::conv_segment(F, (size_t)(sgm >> 4) * SEQ, (sgm & 15) * 128, 128, nullptr);
        for (int bs = F.vcu; bs < SB; bs += F.G) cv::conv_segment(F, (size_t)MP + ST * bs, 0, ST, F.cstate + (size_t)bs * 30 * DM);
        }
        if (BOTH(5)) GRID_BAR();
    }

    if (IN(6)) {
        { sk::SkRes<false> Es{F.xs, F.out, F.XN, F.RS2}; sk::sample_gemm<false>(F, F.A2 + (size_t)MP * DM, F.Wo1t, 4 * (DM / 64), Es); }
        pg8::Gemm g{F.A2, F.Wo1t, MP, DM, DM}; pg8::StaticOrder S; S.init(MP, DM, F.G, (int)blockIdx.x);
        pg8::EpiRes<false> E{F.xp, F.xs, F.out, F.XN, F.RS2};
        pg8::gemm_phase<pg8::EpiRes<false>, pg8::StaticOrder, PG8_ALIGN, PG8_SP2>(F.lds + RING_OFF, g, S, E);
        if (BOTH(6)) GRID_BAR();
    }

    if (IN(7)) {
        const int gw = F.vcu * NWAVES + F.wave, NGW = F.G * NWAVES;
        int m0 = gw;
        for (; m0 + 3 * NGW < MP; m0 += 4 * NGW) {
            f32x4 v[4][4], g[4]; float rs[4];
#pragma unroll
            for (int q = 0; q < 4; ++q) { const int m = m0 + q * NGW; const GAS f32x4* yr = (const GAS f32x4*)(F.out + OFF_YP + (size_t)m * DM) + F.lane;
#pragma unroll
                for (int j = 0; j < 4; ++j) v[q][j] = yr[64 * j]; rs[q] = 1.f / sqrtf(F.RS2[m] * (1.f / DM) + RMS_EPS); }
#pragma unroll
            for (int j = 0; j < 4; ++j) g[j] = ((const GAS f32x4*)F.gf + F.lane)[64 * j];
#pragma unroll
            for (int q = 0; q < 4; ++q) { const int m = m0 + q * NGW; GAS f32x4* yr = (GAS f32x4*)(F.out + OFF_YP + (size_t)m * DM) + F.lane;
#pragma unroll
                for (int j = 0; j < 4; ++j) yr[64 * j] = v[q][j] * rs[q] * g[j]; }
        }
        for (int m = m0; m < MV; m += NGW) {
            float* yrow = m < MP ? F.out + OFF_YP + (size_t)m * DM : F.out + OFF_YS + (size_t)(m - MP) * DM;
            const float rs = 1.f / sqrtf(F.RS2[m] * (1.f / DM) + RMS_EPS);
            GAS f32x4* yr = (GAS f32x4*)yrow + F.lane; const GAS f32x4* gr = (const GAS f32x4*)F.gf + F.lane;
#pragma unroll
            for (int j = 0; j < 4; ++j) yr[64 * j] = yr[64 * j] * rs * gr[64 * j]; }
    }
#undef IN
#undef BOTH
#undef GRID_BAR
}

extern "C" void kernel_launch(void* const* d_in, const int* in_sizes, int n_in, void* d_out, int out_size, void* d_ws, size_t ws_size, hipStream_t stream) {
    static int grid = 0;
    if (grid == 0) {
        if (n_in != 26 || in_sizes[0] != MP * DM || (size_t)out_size != OUT_TOTAL || ws_size < WS_END) {
            fprintf(stderr, "kernel_launch: shape mismatch: n_in %d in0 %d out %d ws %zu (need %zu); nothing launched\n", n_in, n_in > 0 ? in_sizes[0] : -1, out_size, ws_size, (size_t)WS_END); grid = -1; return; }
        int dev = 0, cus = 0, per_cu = 0;
        if (hipGetDevice(&dev) != hipSuccess || hipDeviceGetAttribute(&cus, hipDeviceAttributeMultiprocessorCount, dev) != hipSuccess) { fprintf(stderr, "kernel_launch: device query failed\n"); grid = -1; return; }
        if (hipFuncSetAttribute((const void*)mega_fwd, hipFuncAttributeMaxDynamicSharedMemorySize, LDS_BYTES) != hipSuccess) { fprintf(stderr, "kernel_launch: hipFuncSetAttribute failed\n"); grid = -1; return; }
        if (hipOccupancyMaxActiveBlocksPerMultiprocessor(&per_cu, (const void*)mega_fwd, NWAVES * 64, LDS_BYTES) != hipSuccess || per_cu < 1)
            fprintf(stderr, "kernel_launch: note: occupancy query reports %d workgroups per CU\n", per_cu);
        (void)hipGetLastError();
        grid = cus;
    }
    if (grid < 0) return;
    if (hipMemsetAsync((char*)d_ws + WS_CTL, 0, CTL_ZERO_BYTES, stream) != hipSuccess) { fprintf(stderr, "kernel_launch: hipMemsetAsync failed\n"); return; }
    Args a{};
    for (int i = 0; i < 26; ++i) a.in[i] = (const float*)d_in[i];
    a.out = (float*)d_out; a.ws = (unsigned char*)d_ws;
    for (int li = 0; li < N_LAUNCHES; ++li) {
        a.ph_lo = (N_LAUNCHES == 1) ? 0 : li; a.ph_hi = (N_LAUNCHES == 1) ? N_PHASES : li + 1;
        hipLaunchKernelGGL(mega_fwd, dim3(grid), dim3(NWAVES * 64), LDS_BYTES, stream, a);
        const hipError_t le = hipPeekAtLastError();
        if (le != hipSuccess) { fprintf(stderr, "kernel_launch: launch %d failed: %s\n", li, hipGetErrorName(le)); break; }
    }
}
```
